# Optimizing an MI355X kernel written in HIP

```python
import jax, jax.numpy as jnp
from jax import lax
import numpy as np

D_MODEL = 1024
BATCH = 32
SEQ = 2048
DEPTH = 1

MEM_LEN = 256

HEAD_DIM = 64
NSA_HEADS = D_MODEL // 128
NSA_KV_HEADS = NSA_HEADS // 4
NSA_GROUP = NSA_HEADS // NSA_KV_HEADS
NSA_WIDTH = NSA_HEADS * HEAD_DIM
NSA_KV_WIDTH = NSA_KV_HEADS * HEAD_DIM
CMP_BLOCK = 32
CMP_STRIDE = 16
CMP_HIDDEN = 2 * HEAD_DIM
SLC_BLOCK = 64
N_SELECT = 8
WINDOW = 256
NSA_QBLOCK = SLC_BLOCK

GLA_HEADS = 4
GLA_DK = 64
GLA_DV = 128
GLA_KEY_WIDTH = GLA_HEADS * GLA_DK
GLA_VAL_WIDTH = GLA_HEADS * GLA_DV
GLA_GATE_RANK = 16
GLA_TAU = 16.0
GLA_CHUNK = 64

XATTN_HEADS = 4
XATTN_HEAD_DIM = 128
XATTN_WIDTH = XATTN_HEADS * XATTN_HEAD_DIM

FFN_DIM = 2816
CONV_WIDTH = 3

RMS_EPS = 1e-6
NEG_INF = -1e30

IN_SPLITS = (NSA_WIDTH, 6 * NSA_KV_WIDTH, 3 * NSA_HEADS,
             GLA_KEY_WIDTH, GLA_KEY_WIDTH, GLA_VAL_WIDTH, GLA_VAL_WIDTH, GLA_GATE_RANK,
             2 * D_MODEL)
IN_WIDTH = (NSA_WIDTH + 6 * NSA_KV_WIDTH + 3 * NSA_HEADS + 2 * GLA_KEY_WIDTH
            + 2 * GLA_VAL_WIDTH + GLA_GATE_RANK + 2 * D_MODEL)

kernel_name = "hybrid_nsa_gla_gated_convffn"


def rms_norm(x, g):
    x32 = x.astype(jnp.float32)
    y = x32 * lax.rsqrt(jnp.mean(x32 * x32, axis=-1, keepdims=True) + RMS_EPS)
    return (y * g.astype(jnp.float32)).astype(x.dtype)


def alibi_slopes(n):
    return 2.0 ** (-8.0 * jnp.arange(1, n + 1, dtype=jnp.float32) / n)


def masked_softmax(s, mask):
    s = jnp.where(mask, s, NEG_INF)
    return jnp.where(mask, jax.nn.softmax(s, axis=-1), 0.0)


def compress_blocks(kv, pos_emb, w1, w2):
    B, S, H, dh = kv.shape
    c = kv.reshape(B, S // CMP_STRIDE, CMP_STRIDE, H, dh)
    blocks = jnp.concatenate([c[:, :-1], c[:, 1:]], axis=2) + pos_emb[None, None, :, None, :]
    n_cmp = blocks.shape[1]
    flat = blocks.transpose(0, 1, 3, 2, 4).reshape(B, n_cmp, H, CMP_BLOCK * dh)
    return jax.nn.gelu(flat @ w1) @ w2


def nsa_attention(q, kc, vc, ks, vs, kw, vw, gate_logits,
                  cmp_pos_k, cmp_w1_k, cmp_w2_k, cmp_pos_v, cmp_w1_v, cmp_w2_v):
    B, S = q.shape[:2]
    f32 = jnp.float32
    q = q.reshape(B, S, NSA_KV_HEADS, NSA_GROUP, HEAD_DIM) * (HEAD_DIM ** -0.5)
    kv_shape = (B, S, NSA_KV_HEADS, HEAD_DIM)
    kc, vc, ks, vs, kw, vw = [a.reshape(kv_shape) for a in (kc, vc, ks, vs, kw, vw)]
    gates = jax.nn.sigmoid(gate_logits.astype(f32)).reshape(B, S, NSA_KV_HEADS, NSA_GROUP, 3)
    slopes = alibi_slopes(NSA_HEADS).reshape(NSA_KV_HEADS, NSA_GROUP)

    k_cmp = compress_blocks(kc, cmp_pos_k, cmp_w1_k, cmp_w2_k)
    v_cmp = compress_blocks(vc, cmp_pos_v, cmp_w1_v, cmp_w2_v)
    n_cmp = k_cmp.shape[1]
    cmp_end = jnp.arange(n_cmp) * CMP_STRIDE + CMP_BLOCK - 1

    n_slc = S // SLC_BLOCK
    n_sel = min(N_SELECT, n_slc)
    cmp_tok = jnp.arange(n_cmp)[:, None] * CMP_STRIDE + jnp.arange(CMP_BLOCK)[None, :]
    overlap = jax.nn.one_hot(cmp_tok // SLC_BLOCK, n_slc, dtype=f32).sum(axis=1) / CMP_BLOCK

    ks_blk = ks.reshape(B, n_slc, SLC_BLOCK, NSA_KV_HEADS, HEAD_DIM).transpose(0, 3, 1, 2, 4)
    vs_blk = vs.reshape(B, n_slc, SLC_BLOCK, NSA_KV_HEADS, HEAD_DIM).transpose(0, 3, 1, 2, 4)
    kw_pad = jnp.pad(kw, ((0, 0), (WINDOW, 0), (0, 0), (0, 0)))
    vw_pad = jnp.pad(vw, ((0, 0), (WINDOW, 0), (0, 0), (0, 0)))
    b_ix = jnp.arange(B)[:, None, None, None]
    h_ix = jnp.arange(NSA_KV_HEADS)[None, :, None, None]
    forced_score = float(NSA_GROUP + 1)

    def query_block(i):
        t0 = i * NSA_QBLOCK
        qb = lax.dynamic_slice_in_dim(q, t0, NSA_QBLOCK, axis=1)
        gb = lax.dynamic_slice_in_dim(gates, t0, NSA_QBLOCK, axis=1)
        t = t0 + jnp.arange(NSA_QBLOCK)

        dist = (t[:, None] - cmp_end[None, :]).astype(f32)
        s = jnp.einsum('bqhgd,bnhd->bhgqn', qb, k_cmp).astype(f32)
        s = s - slopes[:, :, None, None] * dist
        p_cmp = masked_softmax(s, dist >= 0)
        o_cmp = jnp.einsum('bhgqn,bnhd->bqhgd', p_cmp.astype(v_cmp.dtype), v_cmp)

        imp = jnp.einsum('bhgqn,nj->bhqj', p_cmp, overlap)
        cur = t // SLC_BLOCK
        j = jnp.arange(n_slc)
        forced = (j[None, :] == 0) | (j[None, :] == cur[:, None]) | (j[None, :] == cur[:, None] - 1)
        future = j[None, :] > cur[:, None]
        imp = jnp.where(forced, forced_score, jnp.where(future, -1.0, imp))
        _, idx = lax.top_k(imp, n_sel)
        kg = ks_blk[b_ix, h_ix, idx]
        vg = vs_blk[b_ix, h_ix, idx]
        kpos = idx[..., None] * SLC_BLOCK + jnp.arange(SLC_BLOCK)
        dist = (t[:, None, None] - kpos).astype(f32)[:, :, None]
        s = jnp.einsum('bqhgd,bhqnld->bhgqnl', qb, kg).astype(f32)
        s = s - slopes[None, :, :, None, None, None] * dist
        n_keys = n_sel * SLC_BLOCK
        s = s.reshape(B, NSA_KV_HEADS, NSA_GROUP, NSA_QBLOCK, n_keys)
        mask = (dist >= 0).reshape(B, NSA_KV_HEADS, 1, NSA_QBLOCK, n_keys)
        p_slc = masked_softmax(s, mask)
        vg = vg.reshape(B, NSA_KV_HEADS, NSA_QBLOCK, n_keys, HEAD_DIM)
        o_slc = jnp.einsum('bhgqk,bhqkd->bqhgd', p_slc.astype(vg.dtype), vg)

        kwb = lax.dynamic_slice_in_dim(kw_pad, t0, NSA_QBLOCK + WINDOW, axis=1)
        vwb = lax.dynamic_slice_in_dim(vw_pad, t0, NSA_QBLOCK + WINDOW, axis=1)
        kpos = t0 - WINDOW + jnp.arange(NSA_QBLOCK + WINDOW)
        dist_i = t[:, None] - kpos[None, :]
        mask = (dist_i >= 0) & (dist_i < WINDOW) & (kpos[None, :] >= 0)
        s = jnp.einsum('bqhgd,bkhd->bhgqk', qb, kwb).astype(f32)
        s = s - slopes[:, :, None, None] * dist_i.astype(f32)
        p_win = masked_softmax(s, mask)
        o_win = jnp.einsum('bhgqk,bkhd->bqhgd', p_win.astype(vwb.dtype), vwb)

        return gb[..., 0:1] * o_cmp + gb[..., 1:2] * o_slc + gb[..., 2:3] * o_win

    out = lax.map(query_block, jnp.arange(S // NSA_QBLOCK))
    out = out.transpose(1, 0, 2, 3, 4, 5).reshape(B, S, NSA_WIDTH)
    return out.astype(q.dtype)


def gla(q, k, v, r, a_low, w_alpha2, b_alpha, norm_g):
    B, S = q.shape[:2]
    f32 = jnp.float32
    nc = S // GLA_CHUNK
    shp_k = (B, nc, GLA_CHUNK, GLA_HEADS, GLA_DK)
    shp_v = (B, nc, GLA_CHUNK, GLA_HEADS, GLA_DV)
    q = q.reshape(shp_k).astype(f32) * (GLA_DK ** -0.5)
    k = k.reshape(shp_k).astype(f32)
    v = v.reshape(shp_v).astype(f32)
    log_a = jax.nn.log_sigmoid((a_low @ w_alpha2 + b_alpha).astype(f32)) / GLA_TAU
    b = jnp.cumsum(log_a.reshape(shp_k), axis=2)
    b_last = b[:, :, -1:]
    q_d = q * jnp.exp(b)
    k_d = k * jnp.exp(-b)
    k_s = k * jnp.exp(b_last - b)
    causal = jnp.tril(jnp.ones((GLA_CHUNK, GLA_CHUNK), dtype=bool))
    att = jnp.where(causal, jnp.einsum('bnihd,bnjhd->bnhij', q_d, k_d), 0.0)
    o_intra = jnp.einsum('bnhij,bnjhe->bnihe', att, v)
    state_inc = jnp.einsum('bnjhd,bnjhe->bnhde', k_s, v)
    decay = jnp.exp(b_last[:, :, 0])

    def step(state, xs):
        dec, inc = xs
        return dec[..., None] * state + inc, state

    init = jnp.zeros((B, GLA_HEADS, GLA_DK, GLA_DV), f32)
    _, states = lax.scan(step, init, (decay.swapaxes(0, 1), state_inc.swapaxes(0, 1)))
    states = states.swapaxes(0, 1)
    o_inter = jnp.einsum('bnihd,bnhde->bnihe', q_d, states)
    o = (o_intra + o_inter).reshape(B, S, GLA_HEADS, GLA_DV)
    o = o * lax.rsqrt(jnp.mean(o * o, axis=-1, keepdims=True) + RMS_EPS) * norm_g.astype(f32)
    o = o * jax.nn.silu(r.reshape(B, S, GLA_HEADS, GLA_DV).astype(f32))
    return o.reshape(B, S, GLA_VAL_WIDTH).astype(r.dtype)


def memory_cross_attention(h, mem_n, w_xq, w_xkv, w_xo):
    B, S = h.shape[:2]
    M = mem_n.shape[1]
    q = (h @ w_xq).reshape(B, S, XATTN_HEADS, XATTN_HEAD_DIM) * (XATTN_HEAD_DIM ** -0.5)
    k, v = jnp.split(mem_n @ w_xkv, 2, axis=-1)
    k = k.reshape(B, M, XATTN_HEADS, XATTN_HEAD_DIM)
    v = v.reshape(B, M, XATTN_HEADS, XATTN_HEAD_DIM)
    p = jax.nn.softmax(jnp.einsum('bshd,bmhd->bhsm', q, k).astype(jnp.float32), axis=-1)
    o = jnp.einsum('bhsm,bmhd->bshd', p.astype(v.dtype), v).reshape(B, S, XATTN_WIDTH)
    return o @ w_xo


def conv_ffn(h, w_up, conv_w, conv_b, w_down):
    S = h.shape[1]
    u, g = jnp.split(h @ w_up, 2, axis=-1)
    u_pad = jnp.pad(u, ((0, 0), (CONV_WIDTH - 1, 0), (0, 0)))
    u = sum(conv_w[tap] * u_pad[:, tap:tap + S] for tap in range(CONV_WIDTH)) + conv_b
    return (jax.nn.gelu(u) * g) @ w_down


def setup_inputs(seed: int = 0) -> dict:
    key = jax.random.key(seed)
    ks = jax.random.split(key, 28)
    f32 = jnp.float32
    L = DEPTH

    def dense(k, shape, fan_in):
        return jax.random.normal(k, shape, f32) * fan_in ** -0.5

    def gain(k, shape):
        return 1.0 + 0.02 * jax.random.normal(k, shape, f32)

    def small(k, shape, scale):
        return scale * jax.random.normal(k, shape, f32)

    return {
        "x": jax.random.normal(ks[0], (BATCH, SEQ, D_MODEL), f32),
        "mem": jax.random.normal(ks[1], (BATCH, MEM_LEN, D_MODEL), f32),
        "ln_mix_g": gain(ks[2], (L, D_MODEL)),
        "w_in": dense(ks[3], (L, D_MODEL, IN_WIDTH), D_MODEL),
        "nsa_gate_b": small(ks[4], (L, 3 * NSA_HEADS), 0.1),
        "cmp_pos_k": small(ks[5], (L, CMP_BLOCK, HEAD_DIM), 0.1),
        "cmp_w1_k": dense(ks[6], (L, CMP_BLOCK * HEAD_DIM, CMP_HIDDEN), CMP_BLOCK * HEAD_DIM),
        "cmp_w2_k": dense(ks[7], (L, CMP_HIDDEN, HEAD_DIM), CMP_HIDDEN),
        "cmp_pos_v": small(ks[8], (L, CMP_BLOCK, HEAD_DIM), 0.1),
        "cmp_w1_v": dense(ks[9], (L, CMP_BLOCK * HEAD_DIM, CMP_HIDDEN), CMP_BLOCK * HEAD_DIM),
        "cmp_w2_v": dense(ks[10], (L, CMP_HIDDEN, HEAD_DIM), CMP_HIDDEN),
        "gla_w_alpha2": dense(ks[11], (L, GLA_GATE_RANK, GLA_KEY_WIDTH), GLA_GATE_RANK),
        "gla_b_alpha": small(ks[12], (L, GLA_KEY_WIDTH), 0.1),
        "gla_norm_g": gain(ks[13], (L, GLA_DV)),
        "w_branch_nsa": dense(ks[14], (L, NSA_WIDTH, D_MODEL), NSA_WIDTH),
        "w_branch_gla": dense(ks[15], (L, GLA_VAL_WIDTH, D_MODEL), GLA_VAL_WIDTH),
        "w_out": dense(ks[16], (L, D_MODEL, D_MODEL), D_MODEL),
        "ln_x_g": gain(ks[17], (L, D_MODEL)),
        "ln_mem_g": gain(ks[18], (L, D_MODEL)),
        "w_xq": dense(ks[19], (L, D_MODEL, XATTN_WIDTH), D_MODEL),
        "w_xkv": dense(ks[20], (L, D_MODEL, 2 * XATTN_WIDTH), D_MODEL),
        "w_xo": dense(ks[21], (L, XATTN_WIDTH, D_MODEL), XATTN_WIDTH),
        "ln_ffn_g": gain(ks[22], (L, D_MODEL)),
        "w_up": dense(ks[23], (L, D_MODEL, 2 * FFN_DIM), D_MODEL),
        "conv_w": dense(ks[24], (L, CONV_WIDTH, FFN_DIM), CONV_WIDTH),
        "conv_b": small(ks[25], (L, FFN_DIM), 0.02),
        "w_down": dense(ks[26], (L, FFN_DIM, D_MODEL), FFN_DIM),
        "ln_final_g": gain(ks[27], (D_MODEL,)),
    }


def reference(x, mem, ln_mix_g, w_in, nsa_gate_b, cmp_pos_k, cmp_w1_k, cmp_w2_k,
              cmp_pos_v, cmp_w1_v, cmp_w2_v, gla_w_alpha2, gla_b_alpha, gla_norm_g,
              w_branch_nsa, w_branch_gla, w_out, ln_x_g, ln_mem_g, w_xq, w_xkv, w_xo,
              ln_ffn_g, w_up, conv_w, conv_b, w_down, ln_final_g):
    split_points = np.cumsum(IN_SPLITS)[:-1].tolist()
    for l in range(DEPTH):
        h = rms_norm(x, ln_mix_g[l])
        q_a, kv_a, gate_a, q_b, k_b, v_b, r_b, alpha_b, merge = jnp.split(h @ w_in[l], split_points, axis=-1)
        kc, vc, ks_, vs_, kw, vw = jnp.split(kv_a, 6, axis=-1)
        o_nsa = nsa_attention(q_a, kc, vc, ks_, vs_, kw, vw, gate_a + nsa_gate_b[l],
                              cmp_pos_k[l], cmp_w1_k[l], cmp_w2_k[l],
                              cmp_pos_v[l], cmp_w1_v[l], cmp_w2_v[l])
        o_gla = gla(q_b, k_b, v_b, r_b, alpha_b, gla_w_alpha2[l], gla_b_alpha[l], gla_norm_g[l])
        g_nsa, g_gla = jnp.split(jax.nn.sigmoid(merge), 2, axis=-1)
        mix = g_nsa * (o_nsa @ w_branch_nsa[l]) + g_gla * (o_gla @ w_branch_gla[l])
        x = x + (mix @ w_out[l]).astype(x.dtype)
        mem_n = rms_norm(mem, ln_mem_g[l])
        x = x + memory_cross_attention(rms_norm(x, ln_x_g[l]), mem_n, w_xq[l], w_xkv[l], w_xo[l]).astype(x.dtype)
        x = x + conv_ffn(rms_norm(x, ln_ffn_g[l]), w_up[l], conv_w[l], conv_b[l], w_down[l]).astype(x.dtype)
    return rms_norm(x, ln_final_g)
```

```cpp
#include <hip/hip_runtime.h>
#include <hip/hip_cooperative_groups.h>
#include <cstdio>
#include <cstdint>
namespace cg = cooperative_groups;
namespace pg8 {
#define PG8_LAS __attribute__((address_space(3)))
typedef unsigned short bf16_t;
typedef short bf16x8 __attribute__((ext_vector_type(8)));
typedef float f32x4 __attribute__((ext_vector_type(4)));
typedef unsigned u32x4 __attribute__((ext_vector_type(4)));
constexpr int BM = 256, BK = 64, HALF = 128, HTB = HALF * BK * 2  , STAGE_BYTES = 8 * HTB, NXCD = 8, WGM = 8;

__host__ __device__ __forceinline__ int lds_byte(int r, int c) { const int st = (r >> 4) * 2 + (c >> 5), rr = r & 15, cc = c & 31, ob = rr * 64 + cc * 2; return st * 1024 + (ob ^ (((ob >> 9) & 1) << 5)); }
__host__ __device__ __forceinline__ void stage_rc(int b, int& R, int& C) { const int st = b / 1024, sb = b % 1024, swz = sb ^ (((sb >> 9) & 1) << 5); R = (st >> 1) * 16 + swz / 64; C = (st & 1) * 32 + (swz % 64) / 2; }
__host__ __device__ __forceinline__ int perm32(int rho) { const int n = rho >> 4, i = rho & 15; return 8 * (i >> 2) + 4 * n + (i & 3); }

struct Unit { int pm, pn; };
struct Gemm { const bf16_t* A; const bf16_t* Bt; int M, N, K; };

struct StaticOrder {
    int nM, nN, nwg, G, c;
    __host__ __device__ void init(int M, int N, int G_, int c_) { nM = M / BM; nN = N / BM; nwg = nM * nN; G = G_; c = c_; }
    __host__ __device__ bool next(int i, Unit& u) const {
        const long L = (long)i * G + c; if (L >= nwg) return false;
        int wgid = (int)L; { const int q = nwg / NXCD, r = nwg % NXCD, xcd = wgid % NXCD, off = wgid / NXCD; wgid = (xcd < r ? xcd * (q + 1) : r * (q + 1) + (xcd - r) * q) + off; }
        const int nig = WGM * nN, gid = wgid / nig, fm = gid * WGM, gsz = (nM - fm) < WGM ? (nM - fm) : WGM;
        u.pm = fm + ((wgid % nig) % gsz); u.pn = (wgid % nig) / gsz; return true;
    }
    __device__ __forceinline__ void a_ready(const Unit&) const {}
    __device__ __forceinline__ void done(const Unit&) const {}
};

__device__ __forceinline__ unsigned cvt_pk_bf16(float lo, float hi) { unsigned r; asm volatile("v_cvt_pk_bf16_f32 %0, %1, %2" : "=v"(r) : "v"(lo), "v"(hi)); return r; }
typedef float f32x2 __attribute__((ext_vector_type(2)));
__device__ __forceinline__ f32x2 gelu_pk(f32x2 v) {
    const f32x2 av = __builtin_elementwise_abs(v), d = av * 0.2316418882f + 1.0f;
    f32x2 t; t.x = __builtin_amdgcn_rcpf(d.x); t.y = __builtin_amdgcn_rcpf(d.y);
    f32x2 q = t * 0.5307027145f + (-0.7265760135f); q = q * t + 0.7107068705f; q = q * t + (-0.142248368f); q = q * t + 0.127414796f; q = q * t;
    const f32x2 s = (v * v) * (-0.72134752044f);
    f32x2 e; e.x = __builtin_amdgcn_exp2f(s.x); e.y = __builtin_amdgcn_exp2f(s.y);
    const f32x2 m = v * (q * e), r = v - m;
    f32x2 o; o.x = v.x < 0.f ? m.x : r.x; o.y = v.y < 0.f ? m.y : r.y; return o;
}

template <int ACT  > struct EpiBf16 {
    static constexpr bool PERM = true, AFTER_DRAIN = false; static_assert(ACT == 0 || ACT == 1, "EpiBf16: ACT is 0 (none) or 1 (gelu_pk)");
    bf16_t* O; int ldc; const float* bias; int split_cols; size_t split_stride; float scale0;
    __device__ __forceinline__ void operator()(const f32x4 (&acc)[2][2][4][2], const Unit& u, int wr, int wc, int fr, int fq) const {
        const int row0 = u.pm * BM + wr * 64 + fr; int colt = u.pn * BM; bf16_t* base = O;
        float sc = 1.f; if (split_cols) { const int t = colt / split_cols; base += (size_t)t * split_stride; colt -= t * split_cols; if (t == 0) sc = scale0; }
        const int col0 = colt + wc * 32 + 8 * fq, bcol0 = u.pn * BM + wc * 32 + 8 * fq;
        f32x4 bv[2][2];
#pragma unroll
        for (int bj = 0; bj < 2; ++bj)
#pragma unroll
            for (int n = 0; n < 2; ++n) bv[bj][n] = bias ? *(const f32x4*)(bias + bcol0 + bj * HALF + 4 * n) : (f32x4){0.f, 0.f, 0.f, 0.f};
#pragma unroll
        for (int ai = 0; ai < 2; ++ai)
#pragma unroll
            for (int m = 0; m < 4; ++m) { bf16_t* rowp = base + (size_t)(row0 + ai * HALF + m * 16) * ldc + col0;
#pragma unroll
                for (int bj = 0; bj < 2; ++bj) { f32x4 v0 = acc[ai][bj][m][0] + bv[bj][0], v1 = acc[ai][bj][m][1] + bv[bj][1];
                    if (ACT == 1) { f32x2 a = gelu_pk((f32x2){v0[0], v0[1]}), b = gelu_pk((f32x2){v0[2], v0[3]}), c = gelu_pk((f32x2){v1[0], v1[1]}), d = gelu_pk((f32x2){v1[2], v1[3]});
                        v0 = (f32x4){a.x, a.y, b.x, b.y}; v1 = (f32x4){c.x, c.y, d.x, d.y}; }
                    v0 = v0 * sc; v1 = v1 * sc; u32x4 w; w.x = cvt_pk_bf16(v0[0], v0[1]); w.y = cvt_pk_bf16(v0[2], v0[3]); w.z = cvt_pk_bf16(v1[0], v1[1]); w.w = cvt_pk_bf16(v1[2], v1[3]);
                    *(u32x4*)(rowp + bj * HALF) = w; } }
    }
};

template <bool BASE_BF16, bool WRITE_F32, bool WRITE_XR>
struct EpiResT {
    static constexpr bool PERM = true, AFTER_DRAIN = false;
    const float* base; float* C; int ldc; bf16_t* XR; float* rowss;
    __device__ __forceinline__ void operator()(const f32x4 (&acc)[2][2][4][2], const Unit& u, int wr, int wc, int fr, int fq) const {
        const int row0 = u.pm * BM + wr * 64 + fr, col0 = u.pn * BM + wc * 32 + 8 * fq;
#pragma unroll
        for (int ai = 0; ai < 2; ++ai) {
            f32x4 b[4][2][2];
#pragma unroll
            for (int m = 0; m < 4; ++m) { const size_t off = (size_t)(row0 + ai * HALF + m * 16) * ldc + col0;
#pragma unroll
                for (int bj = 0; bj < 2; ++bj) {
                    if (BASE_BF16) { const u32x4 w = *(const u32x4*)(XR + off + bj * HALF);
                        b[m][bj][0] = (f32x4){__builtin_bit_cast(float, w.x << 16), __builtin_bit_cast(float, w.x & 0xffff0000u), __builtin_bit_cast(float, w.y << 16), __builtin_bit_cast(float, w.y & 0xffff0000u)};
                        b[m][bj][1] = (f32x4){__builtin_bit_cast(float, w.z << 16), __builtin_bit_cast(float, w.z & 0xffff0000u), __builtin_bit_cast(float, w.w << 16), __builtin_bit_cast(float, w.w & 0xffff0000u)}; }
                    else { b[m][bj][0] = *(const f32x4*)(base + off + bj * HALF); b[m][bj][1] = *(const f32x4*)(base + off + bj * HALF + 4); } } }
            asm volatile("" ::: "memory");
#pragma unroll
            for (int m = 0; m < 4; ++m) { const int row = row0 + ai * HALF + m * 16; const size_t off = (size_t)row * ldc + col0;
                float ss = 0.f;
#pragma unroll
                for (int bj = 0; bj < 2; ++bj) { const size_t o = off + bj * HALF;
                    const f32x4 v0 = b[m][bj][0] + acc[ai][bj][m][0], v1 = b[m][bj][1] + acc[ai][bj][m][1];
                    if (WRITE_F32) { *(f32x4*)(C + o) = v0; *(f32x4*)(C + o + 4) = v1; }
                    if (WRITE_XR) {
                        ss += (v0[0] * v0[0] + v0[1] * v0[1]) + (v0[2] * v0[2] + v0[3] * v0[3]) + (v1[0] * v1[0] + v1[1] * v1[1]) + (v1[2] * v1[2] + v1[3] * v1[3]);
                        u32x4 w; w.x = cvt_pk_bf16(v0[0], v0[1]); w.y = cvt_pk_bf16(v0[2], v0[3]); w.z = cvt_pk_bf16(v1[0], v1[1]); w.w = cvt_pk_bf16(v1[2], v1[3]);
                        *(u32x4*)(XR + o) = w; } }
                if (WRITE_XR) { ss += __shfl_xor(ss, 16); ss += __shfl_xor(ss, 32); if (fq == 0) atomicAdd(rowss + row, ss); } }
        }
    }
};
struct EpiBf16RS {
    static constexpr bool PERM = true, AFTER_DRAIN = false;
    bf16_t* O; int ldc; const float* rowss; float inv_nk, eps;
    __device__ __forceinline__ void operator()(const f32x4 (&acc)[2][2][4][2], const Unit& u, int wr, int wc, int fr, int fq) const {
        const int row0 = u.pm * BM + wr * 64 + fr, col0 = u.pn * BM + wc * 32 + 8 * fq;
        float rsv[2][4];
#pragma unroll
        for (int ai = 0; ai < 2; ++ai)
#pragma unroll
            for (int m = 0; m < 4; ++m) rsv[ai][m] = rowss[row0 + ai * HALF + m * 16];
        asm volatile("" ::: "memory");
#pragma unroll
        for (int ai = 0; ai < 2; ++ai)
#pragma unroll
            for (int m = 0; m < 4; ++m) { const int row = row0 + ai * HALF + m * 16; const float rs = 1.0f / sqrtf(rsv[ai][m] * inv_nk + eps);
                bf16_t* rowp = O + (size_t)row * ldc + col0;
#pragma unroll
                for (int bj = 0; bj < 2; ++bj) { const f32x4 v0 = acc[ai][bj][m][0] * rs, v1 = acc[ai][bj][m][1] * rs;
                    u32x4 w; w.x = cvt_pk_bf16(v0[0], v0[1]); w.y = cvt_pk_bf16(v0[2], v0[3]); w.z = cvt_pk_bf16(v1[0], v1[1]); w.w = cvt_pk_bf16(v1[2], v1[3]);
                    *(u32x4*)(rowp + bj * HALF) = w; } }
    }
};
__device__ __forceinline__ float bf2f(unsigned short b) { return __builtin_bit_cast(float, (unsigned)b << 16); }
__device__ __forceinline__ float sigmoidf_fast(float x) { return __builtin_amdgcn_rcpf(1.0f + __builtin_amdgcn_exp2f(-1.4426950408889634f * x)); }
struct EpiWin {
    static constexpr bool PERM = true, AFTER_DRAIN = false;
    bf16_t* P; int ldp; unsigned char* G8; int ldg;
    __device__ __forceinline__ void operator()(const f32x4 (&acc)[2][2][4][2], const Unit& u, int wr, int wc, int fr, int fq) const {
        const int row0 = u.pm * BM + wr * 64 + fr, cl = wc * 32 + 8 * fq;
        if (u.pn >= 11 && u.pn <= 18) {
            unsigned char* base = G8 + (u.pn - 11) * BM + cl;
#pragma unroll
            for (int ai = 0; ai < 2; ++ai)
#pragma unroll
                for (int m = 0; m < 4; ++m) { unsigned char* rowp = base + (size_t)(row0 + ai * HALF + m * 16) * ldg;
#pragma unroll
                    for (int bj = 0; bj < 2; ++bj) { unsigned q[8];
#pragma unroll
                        for (int e = 0; e < 4; ++e) { q[e] = (unsigned)(sigmoidf_fast(acc[ai][bj][m][0][e]) * 255.0f + 0.5f); q[4 + e] = (unsigned)(sigmoidf_fast(acc[ai][bj][m][1][e]) * 255.0f + 0.5f); }
                        typedef unsigned u32x2 __attribute__((ext_vector_type(2)));
                        u32x2 w; w.x = q[0] | (q[1] << 8) | (q[2] << 16) | (q[3] << 24); w.y = q[4] | (q[5] << 8) | (q[6] << 16) | (q[7] << 24);
                        *(u32x2*)(rowp + bj * HALF) = w; } }
        } else {
            bf16_t* base = P + (u.pn == 19 ? 2816 : u.pn * BM) + cl;
#pragma unroll
            for (int ai = 0; ai < 2; ++ai)
#pragma unroll
                for (int m = 0; m < 4; ++m) { bf16_t* rowp = base + (size_t)(row0 + ai * HALF + m * 16) * ldp;
#pragma unroll
                    for (int bj = 0; bj < 2; ++bj) { const f32x4 v0 = acc[ai][bj][m][0], v1 = acc[ai][bj][m][1];
                        u32x4 w; w.x = cvt_pk_bf16(v0[0], v0[1]); w.y = cvt_pk_bf16(v0[2], v0[3]); w.z = cvt_pk_bf16(v1[0], v1[1]); w.w = cvt_pk_bf16(v1[2], v1[3]);
                        *(u32x4*)(rowp + bj * HALF) = w; } }
        }
    }
};
struct EpiGate {
    static constexpr bool PERM = true, AFTER_DRAIN = false;
    const unsigned char* gate; int ldg; bf16_t* O; int ldc; int accum;
    __device__ __forceinline__ void operator()(const f32x4 (&acc)[2][2][4][2], const Unit& u, int wr, int wc, int fr, int fq) const {
        typedef unsigned u32x2 __attribute__((ext_vector_type(2)));
        const int row0 = u.pm * BM + wr * 64 + fr, col0 = u.pn * BM + wc * 32 + 8 * fq;
#pragma unroll
        for (int ai = 0; ai < 2; ++ai) {
            u32x2 gv[4][2]; u32x4 pv[4][2];
#pragma unroll
            for (int m = 0; m < 4; ++m) { const size_t row = (size_t)(row0 + ai * HALF + m * 16);
#pragma unroll
                for (int bj = 0; bj < 2; ++bj) { gv[m][bj] = *(const u32x2*)(gate + row * ldg + col0 + bj * HALF);
                    pv[m][bj] = accum ? *(const u32x4*)(O + row * ldc + col0 + bj * HALF) : (u32x4){0u, 0u, 0u, 0u}; } }
            asm volatile("" ::: "memory");
#pragma unroll
            for (int m = 0; m < 4; ++m) { const size_t row = (size_t)(row0 + ai * HALF + m * 16);
#pragma unroll
                for (int bj = 0; bj < 2; ++bj) {
                    float g[8], v[8];
#pragma unroll
                    for (int e = 0; e < 4; ++e) { g[e] = (float)((gv[m][bj].x >> (8 * e)) & 0xffu) * (1.0f / 255.0f); g[4 + e] = (float)((gv[m][bj].y >> (8 * e)) & 0xffu) * (1.0f / 255.0f); }
#pragma unroll
                    for (int e = 0; e < 4; ++e) { v[e] = acc[ai][bj][m][0][e] * g[e]; v[4 + e] = acc[ai][bj][m][1][e] * g[4 + e]; }
#pragma unroll
                    for (int e = 0; e < 4; ++e) { v[2 * e] += bf2f((unsigned short)(pv[m][bj][e] & 0xffffu)); v[2 * e + 1] += bf2f((unsigned short)(pv[m][bj][e] >> 16)); }
                    u32x4 w; w.x = cvt_pk_bf16(v[0], v[1]); w.y = cvt_pk_bf16(v[2], v[3]); w.z = cvt_pk_bf16(v[4], v[5]); w.w = cvt_pk_bf16(v[6], v[7]);
                    *(u32x4*)(O + row * ldc + col0 + bj * HALF) = w; } }
        }
    }
};
struct EpiFinalNorm {
    static constexpr bool PERM = true, AFTER_DRAIN = false;
    const bf16_t* XR; float* out; int ldc; const float* gain; float* slots; unsigned* cnt; unsigned* tmo; PG8_LAS float* tab; float inv_nk, eps;
    __device__ __forceinline__ void operator()(f32x4 (&acc)[2][2][4][2], const Unit& u, int wr, int wc, int fr, int fq) const {
        const int row0 = u.pm * BM + wr * 64 + fr, col0 = u.pn * BM + wc * 32 + 8 * fq;
        const int lane = fr | (fq << 4), wid = 4 * wr + wc, tid = wid * 64 + lane;
        PG8_LAS float* Pst = tab; PG8_LAS float* Srow = tab + 1024; PG8_LAS unsigned* flag = (PG8_LAS unsigned*)(tab + 1280);
#pragma unroll
        for (int ai = 0; ai < 2; ++ai) {
            u32x4 b[4][2];
#pragma unroll
            for (int m = 0; m < 4; ++m)
#pragma unroll
                for (int bj = 0; bj < 2; ++bj) b[m][bj] = *(const u32x4*)(XR + (size_t)(row0 + ai * HALF + m * 16) * ldc + col0 + bj * HALF);
#pragma unroll
            for (int m = 0; m < 4; ++m) { float ss = 0.f;
#pragma unroll
                for (int bj = 0; bj < 2; ++bj) { const u32x4 w = b[m][bj];
                    const f32x4 x0 = {__builtin_bit_cast(float, w.x << 16), __builtin_bit_cast(float, w.x & 0xffff0000u), __builtin_bit_cast(float, w.y << 16), __builtin_bit_cast(float, w.y & 0xffff0000u)};
                    const f32x4 x1 = {__builtin_bit_cast(float, w.z << 16), __builtin_bit_cast(float, w.z & 0xffff0000u), __builtin_bit_cast(float, w.w << 16), __builtin_bit_cast(float, w.w & 0xffff0000u)};
                    const f32x4 v0 = acc[ai][bj][m][0] + x0, v1 = acc[ai][bj][m][1] + x1; acc[ai][bj][m][0] = v0; acc[ai][bj][m][1] = v1;
                    ss += (v0[0] * v0[0] + v0[1] * v0[1]) + (v0[2] * v0[2] + v0[3] * v0[3]) + (v1[0] * v1[0] + v1[1] * v1[1]) + (v1[2] * v1[2] + v1[3] * v1[3]); }
                ss += __shfl_xor(ss, 16); ss += __shfl_xor(ss, 32);
                if (fq == 0) Pst[(ai * HALF + wr * 64 + m * 16 + fr) * 4 + wc] = ss; }
        }
        asm volatile("s_waitcnt lgkmcnt(0)" ::: "memory"); __builtin_amdgcn_s_barrier(); asm volatile("" ::: "memory");
        if (tid < 256) { const float t = (Pst[tid * 4 + 0] + Pst[tid * 4 + 1]) + (Pst[tid * 4 + 2] + Pst[tid * 4 + 3]);
            __hip_atomic_store(slots + ((size_t)(u.pm * BM + tid) * 4 + u.pn), t, __ATOMIC_RELAXED, __HIP_MEMORY_SCOPE_AGENT); }
        asm volatile("s_waitcnt vmcnt(0)" ::: "memory");
        if (lane == 0) __hip_atomic_fetch_add(cnt + 64 * u.pm, 1u, __ATOMIC_RELAXED, __HIP_MEMORY_SCOPE_AGENT);
        if (wid == 0) {
            bool dead = false; unsigned spins = 0;
            while ((unsigned)__builtin_amdgcn_readfirstlane(__hip_atomic_load(cnt + 64 * u.pm, __ATOMIC_RELAXED, __HIP_MEMORY_SCOPE_AGENT)) < 32u) {
                __builtin_amdgcn_s_sleep(2);
                if (++spins > (1u << 22)) { if (lane == 0) __hip_atomic_store(tmo, 1u, __ATOMIC_RELAXED, __HIP_MEMORY_SCOPE_AGENT); dead = true; break; } }
            __builtin_amdgcn_fence(__ATOMIC_ACQUIRE, "agent");
            if (lane == 0) flag[0] = dead ? 1u : 0u;
        }
        asm volatile("s_waitcnt vmcnt(0) lgkmcnt(0)" ::: "memory"); __builtin_amdgcn_s_barrier(); asm volatile("" ::: "memory");
        if (tid < 256) { const float* sl = slots + (size_t)(u.pm * BM + tid) * 4; float t = 0.f;
#pragma unroll
            for (int k = 0; k < 4; ++k) t += __hip_atomic_load(sl + k, __ATOMIC_RELAXED, __HIP_MEMORY_SCOPE_AGENT);
            Srow[tid] = __builtin_amdgcn_rsqf(t * inv_nk + eps); }
        asm volatile("s_waitcnt vmcnt(0) lgkmcnt(0)" ::: "memory"); __builtin_amdgcn_s_barrier(); asm volatile("" ::: "memory");
        f32x4 gv[2][2];
#pragma unroll
        for (int bj = 0; bj < 2; ++bj) { gv[bj][0] = *(const f32x4*)(gain + col0 + bj * HALF); gv[bj][1] = *(const f32x4*)(gain + col0 + bj * HALF + 4); }
#pragma unroll
        for (int ai = 0; ai < 2; ++ai)
#pragma unroll
            for (int m = 0; m < 4; ++m) { const int rl = ai * HALF + wr * 64 + m * 16 + fr; const float rs = Srow[rl]; float* op = out + (size_t)(u.pm * BM + rl) * ldc + col0;
#pragma unroll
                for (int bj = 0; bj < 2; ++bj) { *(f32x4*)(op + bj * HALF) = acc[ai][bj][m][0] * rs * gv[bj][0]; *(f32x4*)(op + bj * HALF + 4) = acc[ai][bj][m][1] * rs * gv[bj][1]; } }
    }
};
__device__ __forceinline__ float gelu_tanh_f(float x) {
    const float z = x * (1.5957691216057308f + 0.07135481627260025f * x * x);
    return x * __builtin_amdgcn_rcpf(1.0f + __builtin_amdgcn_exp2f(-1.4426950408889634f * z));
}
template <int CTRL> __device__ __forceinline__ float dpp_rot(float v) { return __builtin_bit_cast(float, __builtin_amdgcn_update_dpp(0, __builtin_bit_cast(int, v), CTRL, 0xF, 0xF, false)); }
struct EpiFfnAct {
    static constexpr bool PERM = true, AFTER_DRAIN = false;
    bf16_t* ACT; int ldc; const float* conv_w; const float* conv_b; int nch; float* SIDE_U; float* SIDE_G; PG8_LAS float* halo; const float* rowss; float inv_nk, eps;
    __device__ __forceinline__ void operator()(f32x4 (&acc)[2][2][4][2], const Unit& u, int wr, int wc, int fr, int fq) const {
        const int chl = wc * 32 + 8 * fq, chg = u.pn * 128 + chl, rbase = u.pm * BM + wr * 64;
        float rs[2][4], rh[2][2];
#pragma unroll
        for (int ai = 0; ai < 2; ++ai) {
#pragma unroll
            for (int m = 0; m < 4; ++m) rs[ai][m] = rowss[rbase + ai * HALF + m * 16 + fr];
            const int r0 = rbase + ai * HALF; rh[ai][0] = rowss[r0 >= 2 ? r0 - 2 : 0]; rh[ai][1] = rowss[r0 >= 1 ? r0 - 1 : 0];
        }
        f32x4 w0[2], w1[2], w2[2], cb[2];
#pragma unroll
        for (int n = 0; n < 2; ++n) { w0[n] = *(const f32x4*)(conv_w + chg + 4 * n); w1[n] = *(const f32x4*)(conv_w + nch + chg + 4 * n); w2[n] = *(const f32x4*)(conv_w + 2 * nch + chg + 4 * n); cb[n] = *(const f32x4*)(conv_b + chg + 4 * n); }
        if (fr >= 14) {
#pragma unroll
            for (int ai = 0; ai < 2; ++ai)
#pragma unroll
                for (int n = 0; n < 2; ++n) *(PG8_LAS f32x4*)(halo + ((2 * ai + wr) * 2 + (fr - 14)) * 128 + chl + 4 * n) = acc[ai][0][3][n];
        }
        asm volatile("s_waitcnt lgkmcnt(0)" ::: "memory"); __builtin_amdgcn_s_barrier(); asm volatile("" ::: "memory");
#pragma unroll
        for (int ai = 0; ai < 2; ++ai) {
            const int k = 2 * ai + wr;
            f32x4 p1[2], p2[2];
            if (k >= 1) {
                const float s2 = 1.0f / sqrtf(rh[ai][0] * inv_nk + eps), s1 = 1.0f / sqrtf(rh[ai][1] * inv_nk + eps);
#pragma unroll
                for (int n = 0; n < 2; ++n) { const f32x4 h2 = *(const PG8_LAS f32x4*)(halo + ((k - 1) * 2 + 0) * 128 + chl + 4 * n) * s2, h1 = *(const PG8_LAS f32x4*)(halo + ((k - 1) * 2 + 1) * 128 + chl + 4 * n) * s1;
                    p1[n] = h1;
#pragma unroll
                    for (int e = 0; e < 4; ++e) p2[n][e] = fr == 0 ? h2[e] : h1[e]; }
            } else {
#pragma unroll
                for (int n = 0; n < 2; ++n) { p1[n] = (f32x4){0.f, 0.f, 0.f, 0.f}; p2[n] = (f32x4){0.f, 0.f, 0.f, 0.f}; }
            }
#pragma unroll
            for (int m = 0; m < 4; ++m) {
                const float rsm = 1.0f / sqrtf(rs[ai][m] * inv_nk + eps);
                const size_t row = (size_t)(rbase + ai * HALF + m * 16 + fr);
                float o[8];
#pragma unroll
                for (int n = 0; n < 2; ++n) {
                    acc[ai][0][m][n] = acc[ai][0][m][n] * rsm; acc[ai][1][m][n] = acc[ai][1][m][n] * rsm;
#pragma unroll
                    for (int e = 0; e < 4; ++e) {
                        const float cur = acc[ai][0][m][n][e];
                        const float r1 = dpp_rot<0x121>(cur), r2 = dpp_rot<0x122>(cur);
                        const float um1 = fr >= 1 ? r1 : p1[n][e], um2 = fr >= 2 ? r2 : p2[n][e];
                        p1[n][e] = r1; p2[n][e] = r2;
                        const float cv = w0[n][e] * um2 + w1[n][e] * um1 + w2[n][e] * cur + cb[n][e];
                        o[4 * n + e] = gelu_tanh_f(cv) * acc[ai][1][m][n][e];
                    }
                }
                u32x4 w; w.x = cvt_pk_bf16(o[0], o[1]); w.y = cvt_pk_bf16(o[2], o[3]); w.z = cvt_pk_bf16(o[4], o[5]); w.w = cvt_pk_bf16(o[6], o[7]);
                *(u32x4*)(ACT + row * ldc + chg) = w;
            }
        }
        if (wr == 0 && fr < 2) {
#pragma unroll
            for (int n = 0; n < 2; ++n) { *(f32x4*)(SIDE_U + ((size_t)u.pm * 4 + fr) * nch + chg + 4 * n) = acc[0][0][0][n]; *(f32x4*)(SIDE_G + ((size_t)u.pm * 2 + fr) * nch + chg + 4 * n) = acc[0][1][0][n]; }
        }
        if (wr == 1 && fr >= 14) {
#pragma unroll
            for (int n = 0; n < 2; ++n) *(f32x4*)(SIDE_U + ((size_t)u.pm * 4 + 2 + (fr - 14)) * nch + chg + 4 * n) = acc[1][0][3][n];
        }
    }
};

template <class Epi, class Sched, bool ALIGN_EPI = false, bool SP2 = false>
__device__ __forceinline__ void gemm_phase(PG8_LAS unsigned char* lds, const Gemm g, const Sched& S, const Epi& E) {
    int tid_ = threadIdx.x; asm volatile("" : "+v"(tid_)); const int tid = tid_, wid = __builtin_amdgcn_readfirstlane(tid >> 6), lane = tid & 63, wr = wid >> 2, wc = wid & 3, fr = lane & 15, fq = lane >> 4;
    const int K = g.K, nt = K / BK;
    unsigned voffA[2], voffB[2];
#pragma unroll
    for (int i = 0; i < 2; ++i) { int R, C; stage_rc(tid * 16 + i * 8192, R, C); const int Rb = Epi::PERM ? ((R & ~31) + perm32(R & 31)) : R;
        voffA[i] = (unsigned)(R * K + C) * 2u; voffB[i] = (unsigned)(Rb * K + C) * 2u; }
    const size_t kstep = (size_t)(BK * 2);
    const size_t hstep = (size_t)HALF * K * 2;
    const size_t tstep = 2 * hstep;
    const unsigned ldsw = (unsigned)wid * 1024u;
    const int aoff = lds_byte(wr * 64 + fr, fq * 8), boff = lds_byte(wc * 32 + fr, fq * 8);
#define PG8_SA(b, h) (((b) * 2 + (h)) * HTB)
#define PG8_SB(b, h) ((4 + (b) * 2 + (h)) * HTB)
#define PG8_STAGE(bufoff, gbase, voff) do { _Pragma("unroll") for (int _i = 0; _i < 2; ++_i) \
        __builtin_amdgcn_global_load_lds((const unsigned*)((const char*)(gbase) + (voff)[_i]), (PG8_LAS unsigned*)(lds + (bufoff) + ldsw + _i * 8192), 16, 0, 0); } while (0)
#define PG8_LDA(dst, b, h) do { _Pragma("unroll") for (int m = 0; m < 4; ++m) _Pragma("unroll") for (int k = 0; k < 2; ++k) dst[m][k] = *(const PG8_LAS bf16x8*)(lds + PG8_SA(b, h) + aoff + m * 2048 + k * 1024); } while (0)
#define PG8_LDB(dst, b, h) do { _Pragma("unroll") for (int n = 0; n < 2; ++n) _Pragma("unroll") for (int k = 0; k < 2; ++k) dst[n][k] = *(const PG8_LAS bf16x8*)(lds + PG8_SB(b, h) + boff + n * 2048 + k * 1024); } while (0)
#define PG8_MMA(ai, bj, At, Bt) do { __builtin_amdgcn_s_setprio(1); _Pragma("unroll") for (int m = 0; m < 4; ++m) _Pragma("unroll") for (int n = 0; n < 2; ++n) _Pragma("unroll") for (int k = 0; k < 2; ++k) \
        acc[ai][bj][m][n] = __builtin_amdgcn_mfma_f32_16x16x32_bf16(Bt[n][k], At[m][k], acc[ai][bj][m][n], 0, 0, 0); __builtin_amdgcn_s_setprio(0); } while (0)
#define PG8_WAIT_V(n) asm volatile("s_waitcnt vmcnt(" #n ")" ::: "memory")
#define PG8_WAIT_L(n) asm volatile("s_waitcnt lgkmcnt(" #n ")" ::: "memory")
#define PG8_BAR __builtin_amdgcn_s_barrier()
#define PG8_SCHED __builtin_amdgcn_sched_barrier(0)
    Unit cur, nxt; int ui = 0;
    if (!S.next(0, cur)) return;
    f32x4 acc[2][2][4][2];
#pragma unroll
    for (int a = 0; a < 2; ++a)
#pragma unroll
        for (int b = 0; b < 2; ++b)
#pragma unroll
            for (int m = 0; m < 4; ++m)
#pragma unroll
                for (int n = 0; n < 2; ++n) acc[a][b][m][n] = (f32x4){0.f, 0.f, 0.f, 0.f};
    bf16x8 At[4][2], B0[2][2], B1[2][2];
    const char* cA = (const char*)g.A + (size_t)cur.pm * tstep; const char* cB = (const char*)g.Bt + (size_t)cur.pn * tstep;
    S.a_ready(cur);
    if constexpr (SP2) {
        PG8_STAGE(PG8_SB(0, 0), cB, voffB); PG8_STAGE(PG8_SB(0, 1), cB + hstep, voffB); PG8_STAGE(PG8_SA(0, 0), cA, voffA); PG8_STAGE(PG8_SA(0, 1), cA + hstep, voffA);
        if (wr == 1) PG8_BAR;
        PG8_WAIT_V(2); PG8_BAR;
        PG8_STAGE(PG8_SB(1, 0), cB + kstep, voffB); PG8_STAGE(PG8_SA(1, 0), cA + kstep, voffA); PG8_STAGE(PG8_SB(1, 1), cB + hstep + kstep, voffB);
        PG8_WAIT_V(6); PG8_BAR;
    } else {
        PG8_STAGE(PG8_SB(0, 0), cB, voffB); PG8_STAGE(PG8_SA(0, 0), cA, voffA); PG8_STAGE(PG8_SB(0, 1), cB + hstep, voffB); PG8_STAGE(PG8_SA(0, 1), cA + hstep, voffA);
        if (wr == 1) PG8_BAR;
        PG8_WAIT_V(4); PG8_BAR;
        PG8_STAGE(PG8_SB(1, 0), cB + kstep, voffB); PG8_STAGE(PG8_SA(1, 0), cA + kstep, voffA); PG8_STAGE(PG8_SB(1, 1), cB + hstep + kstep, voffB);
        PG8_WAIT_V(6); PG8_BAR;
    }
    for (;;) {
        const bool has_next = S.next(ui + 1, nxt);
        const char* nA = has_next ? (const char*)g.A + (size_t)nxt.pm * tstep : cA; const char* nB = has_next ? (const char*)g.Bt + (size_t)nxt.pn * tstep : cB;
        for (int t = 0; t < nt; t += 2) {
            const bool last = (t == nt - 2);
            const char* a1 = cA + (size_t)(t + 1) * kstep;
            const char* a2 = last ? nA : cA + (size_t)(t + 2) * kstep; const char* b2 = last ? nB : cB + (size_t)(t + 2) * kstep;
            const char* a3 = a2 + kstep; const char* b3 = b2 + kstep;
            if (last && has_next) S.a_ready(nxt);
            if constexpr (SP2) {
            PG8_LDB(B0, 0, 0); PG8_LDB(B1, 0, 1); PG8_SCHED; PG8_LDA(At, 0, 0); PG8_STAGE(PG8_SA(1, 1), a1 + hstep, voffA);
            PG8_WAIT_V(8); PG8_WAIT_L(0); PG8_BAR; PG8_MMA(0, 0, At, B0); PG8_MMA(0, 1, At, B1); PG8_BAR; PG8_SCHED;
            PG8_LDA(At, 0, 1); PG8_STAGE(PG8_SB(0, 0), b2, voffB); PG8_STAGE(PG8_SB(0, 1), b2 + hstep, voffB); PG8_STAGE(PG8_SA(0, 0), a2, voffA);
            PG8_WAIT_V(8); PG8_WAIT_L(0); PG8_BAR; PG8_MMA(1, 0, At, B0); PG8_MMA(1, 1, At, B1); PG8_BAR; PG8_SCHED;
            PG8_LDB(B0, 1, 0); PG8_LDB(B1, 1, 1); PG8_SCHED; PG8_LDA(At, 1, 0); PG8_STAGE(PG8_SA(0, 1), a2 + hstep, voffA);
            PG8_WAIT_V(8); PG8_WAIT_L(0); PG8_BAR; PG8_MMA(0, 0, At, B0); PG8_MMA(0, 1, At, B1); PG8_BAR; PG8_SCHED;
            PG8_LDA(At, 1, 1); PG8_STAGE(PG8_SB(1, 0), b3, voffB); PG8_STAGE(PG8_SB(1, 1), b3 + hstep, voffB); PG8_STAGE(PG8_SA(1, 0), a3, voffA);
            PG8_WAIT_V(8); PG8_WAIT_L(0); PG8_BAR; PG8_MMA(1, 0, At, B0); PG8_MMA(1, 1, At, B1); PG8_BAR; PG8_SCHED;
            } else {
            PG8_LDB(B0, 0, 0); PG8_SCHED; PG8_LDA(At, 0, 0); PG8_STAGE(PG8_SA(1, 1), a1 + hstep, voffA);
            PG8_WAIT_L(8); PG8_BAR; PG8_WAIT_L(0); PG8_MMA(0, 0, At, B0); PG8_BAR; PG8_SCHED;
            PG8_LDB(B1, 0, 1); PG8_STAGE(PG8_SB(0, 0), b2, voffB);
            PG8_BAR; PG8_WAIT_L(0); PG8_MMA(0, 1, At, B1); PG8_BAR;
            PG8_LDA(At, 0, 1); PG8_STAGE(PG8_SA(0, 0), a2, voffA);
            PG8_BAR; PG8_WAIT_L(0); PG8_MMA(1, 0, At, B0); PG8_BAR; PG8_SCHED;
            PG8_STAGE(PG8_SB(0, 1), b2 + hstep, voffB);
            PG8_WAIT_V(6); PG8_BAR; PG8_MMA(1, 1, At, B1); PG8_BAR;
            PG8_LDB(B0, 1, 0); PG8_SCHED; PG8_LDA(At, 1, 0); PG8_STAGE(PG8_SA(0, 1), a2 + hstep, voffA);
            PG8_WAIT_L(8); PG8_BAR; PG8_WAIT_L(0); PG8_MMA(0, 0, At, B0); PG8_BAR; PG8_SCHED;
            PG8_LDB(B1, 1, 1); PG8_STAGE(PG8_SB(1, 0), b3, voffB);
            PG8_BAR; PG8_WAIT_L(0); PG8_MMA(0, 1, At, B1); PG8_BAR;
            PG8_LDA(At, 1, 1); PG8_STAGE(PG8_SA(1, 0), a3, voffA);
            PG8_BAR; PG8_WAIT_L(0); PG8_MMA(1, 0, At, B0); PG8_BAR; PG8_SCHED;
            PG8_STAGE(PG8_SB(1, 1), b3 + hstep, voffB);
            PG8_WAIT_V(6); PG8_BAR; PG8_MMA(1, 1, At, B1); PG8_BAR;
            }
        }
        if constexpr (ALIGN_EPI) { if (wr == 0) PG8_BAR; }
        if constexpr (!Epi::AFTER_DRAIN) { E(acc, cur, wr, wc, fr, fq); S.done(cur); }
        if (!has_next) break;
#pragma unroll
        for (int a = 0; a < 2; ++a)
#pragma unroll
            for (int b = 0; b < 2; ++b)
#pragma unroll
                for (int m = 0; m < 4; ++m)
#pragma unroll
                    for (int n = 0; n < 2; ++n) acc[a][b][m][n] = (f32x4){0.f, 0.f, 0.f, 0.f};
        cur = nxt; cA = nA; cB = nB; ++ui;
        if constexpr (ALIGN_EPI) { if (wr == 1) PG8_BAR; }
    }
    PG8_WAIT_V(0);
    if constexpr (!ALIGN_EPI) { if (wr == 0) PG8_BAR; }
    PG8_BAR;
    if constexpr (Epi::AFTER_DRAIN) { E.fused(acc, cur, wr, wc, fr, fq, lds, wid, lane); S.done(cur); }
#undef PG8_SA
#undef PG8_SB
#undef PG8_STAGE
#undef PG8_LDA
#undef PG8_LDB
#undef PG8_MMA
#undef PG8_WAIT_V
#undef PG8_WAIT_L
#undef PG8_BAR
#undef PG8_SCHED
}
}

constexpr int NWAVES = 8, NTHREADS = 512;
constexpr int BATCH = 32, SEQ = 2048, DM = 1024, T = BATCH * SEQ;
constexpr int MEM_LEN = 256, TM = BATCH * MEM_LEN;
constexpr int FFN = 2816, FFN2 = 2 * FFN;
constexpr float RMS_EPS = 1e-6f;
constexpr float LOG2E = 1.4426950408889634f;
constexpr int PLD = 3072, NWIN = 5120, IN_W = 4904;
constexpr int COL_QA = 0, COL_KC = 512, COL_VC = 640, COL_KS = 768, COL_VS = 896, COL_KW = 1024, COL_VW = 1152, COL_QB = 1280, COL_KB = 1536, COL_VB = 1792, COL_RB = 2304,
              COL_GATE = 2816, COL_ALPHA = 2840;
constexpr int WROW_GN = 2816, WROW_TAIL = 4864, WROW_ALPHA = 4888;
constexpr int G8LD = 2048;

constexpr size_t MiB = 1u << 20, KiB = 1u << 10;
constexpr size_t WS_CTL = 0;
constexpr size_t WS_ROWSS = 64 * KiB;
constexpr size_t WS_WIN = 1 * MiB;
constexpr size_t WS_WUP = 11 * MiB;
constexpr size_t WS_WDOWN = 22 * MiB;
constexpr size_t WS_WXKV = 28 * MiB;
constexpr size_t WS_WOUT = 30 * MiB;
constexpr size_t WS_WBN = 32 * MiB;
constexpr size_t WS_WBG = 33 * MiB;
constexpr size_t WS_WXQ = 34 * MiB;
constexpr size_t WS_WXO = 35 * MiB;
constexpr size_t WS_W1K = 36 * MiB;
constexpr size_t WS_W1V = 36 * MiB + 512 * KiB;
constexpr size_t WS_W2K = 37 * MiB;
constexpr size_t WS_W2V = 37 * MiB + 16 * KiB;
constexpr size_t WS_C1 = 37 * MiB + 32 * KiB;
constexpr size_t WS_A = 48 * MiB;
constexpr size_t WS_XN0 = WS_A;
constexpr size_t WS_XN = 176 * MiB + 512 * MiB;
constexpr size_t WS_VST = WS_A;
constexpr size_t WS_VWT = WS_A + 16 * MiB;
constexpr size_t WS_KCMP = WS_A + 32 * MiB;
constexpr size_t WS_VCMPT = WS_A + 33 * MiB;
constexpr size_t WS_MIX = WS_A;
constexpr size_t WS_B = 176 * MiB;
constexpr size_t WS_P = WS_B;
constexpr size_t WS_G8 = WS_B + 384 * MiB;
constexpr size_t WS_XQ = WS_B;
constexpr size_t WS_XO = WS_B + 64 * MiB;
constexpr size_t WS_ACT = WS_B;
constexpr size_t WS_C = 816 * MiB;
constexpr size_t WS_MEMN = WS_C;
constexpr size_t WS_MEMKV = WS_C + 16 * MiB;
constexpr size_t WS_ONSA = WS_C + 32 * MiB;
constexpr size_t WS_OGLA = WS_C + 96 * MiB;
constexpr size_t WS_MEMVT2 = WS_C + 160 * MiB;
constexpr size_t WS_FSLOT = WS_C + 32 * MiB;
constexpr size_t WS_SIDEU = WS_C;
constexpr size_t WS_SIDEG = WS_C + 16 * MiB;
constexpr size_t WS_END = 1024 * MiB;

constexpr int LDS_BYTES = 147456;

#define LAS __attribute__((address_space(3)))
typedef unsigned short bf16;
typedef unsigned v4u __attribute__((ext_vector_type(4)));
typedef unsigned v2u __attribute__((ext_vector_type(2)));
typedef float f32x4 __attribute__((ext_vector_type(4)));
typedef float f32x16 __attribute__((ext_vector_type(16)));
typedef short bf16x8 __attribute__((ext_vector_type(8)));
#define LDS_WAIT() asm volatile("s_waitcnt lgkmcnt(0)" ::: "memory")
#define MFMA32(a, b, c) __builtin_amdgcn_mfma_f32_32x32x16_bf16((a), (b), (c), 0, 0, 0)

typedef float f32x2_t __attribute__((ext_vector_type(2))); typedef __bf16 bf16x2_t __attribute__((ext_vector_type(2)));
__device__ __forceinline__ unsigned pk2(float lo, float hi) { const f32x2_t v = {lo, hi}; return __builtin_bit_cast(unsigned, __builtin_convertvector(v, bf16x2_t)); }
__device__ __forceinline__ unsigned f2bf(float f) { return pk2(f, 0.f) & 0xffffu; }
__device__ __forceinline__ float bflo(unsigned w) { return __builtin_bit_cast(float, w << 16); }
__device__ __forceinline__ float bfhi(unsigned w) { return __builtin_bit_cast(float, w & 0xffff0000u); }
__device__ __forceinline__ float bf2f(bf16 b) { return __builtin_bit_cast(float, (unsigned)b << 16); }
__device__ __forceinline__ float ex2(float x) { return __builtin_amdgcn_exp2f(x); }
__device__ __forceinline__ float sigmoid_f(float x) { return __builtin_amdgcn_rcpf(1.0f + ex2(-LOG2E * x)); }
__device__ __forceinline__ int crow(int r, int g) { return (r & 3) + 8 * (r >> 2) + 4 * g; }
__device__ __forceinline__ int launder(int v) { asm volatile("" : "+v"(v)); return v; }
__device__ __forceinline__ float wave_sum(float v) {
#pragma unroll
    for (int o = 1; o < 64; o <<= 1) v += __shfl_xor(v, o);
    return v;
}
__device__ __forceinline__ f32x16 zero16() { f32x16 z;
#pragma unroll
    for (int r = 0; r < 16; ++r) z[r] = 0.f;
    return z; }
__device__ __forceinline__ float gelu_tanh(float x) {
    const float z = x * (1.5957691216057308f + 0.07135481627260025f * x * x);
    return x * __builtin_amdgcn_rcpf(1.0f + ex2(-LOG2E * z));
}
__device__ __forceinline__ bf16x8 pack8(const float* p) { v4u w; w.x = pk2(p[0], p[1]); w.y = pk2(p[2], p[3]); w.z = pk2(p[4], p[5]); w.w = pk2(p[6], p[7]); return __builtin_bit_cast(bf16x8, w); }

__device__ __forceinline__ void transpose_item(const float* W, int ldw, int K, int ncols, bf16* WT, int row_off, float scale, LAS float* scr, int item, int lane, const float* kscale = nullptr) {
    const int nblk = ncols / 32, kb = item / nblk, nb = item % nblk, k0 = 64 * kb, n0 = 32 * nb;
    float wv[32];
#pragma unroll
    for (int i = 0; i < 32; ++i) wv[i] = __builtin_nontemporal_load(W + (size_t)(k0 + 2 * i + (lane >> 5)) * ldw + n0 + (lane & 31));
#pragma unroll
    for (int i = 0; i < 32; ++i) { const int kk = 2 * i + (lane >> 5); scr[kk * 33 + (lane & 31)] = wv[i] * (kscale ? scale * kscale[k0 + kk] : scale); }
    LDS_WAIT(); asm volatile("" ::: "memory");
    const int c = lane & 7;
#pragma unroll
    for (int j = 0; j < 4; ++j) { const int n = (lane >> 3) + 8 * j; const LAS float* s = scr + (8 * c) * 33 + n;
        v4u o; o.x = pk2(s[0 * 33], s[1 * 33]); o.y = pk2(s[2 * 33], s[3 * 33]); o.z = pk2(s[4 * 33], s[5 * 33]); o.w = pk2(s[6 * 33], s[7 * 33]);
        *(v4u*)(WT + (size_t)(row_off + n0 + n) * K + k0 + 8 * c) = o; }
    LDS_WAIT(); asm volatile("" ::: "memory");
}

__device__ __forceinline__ void rms_rows_bf16(const float* X, const float* g, bf16* O, int nrows, int gw, int NGW, int lane) {
    f32x4 gv[4];
#pragma unroll
    for (int j = 0; j < 4; ++j) gv[j] = *((const f32x4*)g + lane + 64 * j);
    for (int m0 = 4 * gw; m0 < nrows; m0 += 4 * NGW) {
        f32x4 v[4][4];
#pragma unroll
        for (int r = 0; r < 4; ++r) { const f32x4* xr = (const f32x4*)(X + (size_t)(m0 + r) * DM) + lane;
#pragma unroll
            for (int j = 0; j < 4; ++j) v[r][j] = __builtin_nontemporal_load(xr + 64 * j); }
#pragma unroll
        for (int r = 0; r < 4; ++r) asm volatile("" :: "v"(v[r][0]), "v"(v[r][1]), "v"(v[r][2]), "v"(v[r][3]));
#pragma unroll
        for (int r = 0; r < 4; ++r) {
            float s = 0.f;
#pragma unroll
            for (int j = 0; j < 4; ++j) s += (v[r][j].x * v[r][j].x + v[r][j].y * v[r][j].y) + (v[r][j].z * v[r][j].z + v[r][j].w * v[r][j].w);
            const float rstd = __builtin_amdgcn_rsqf(wave_sum(s) * (1.0f / DM) + RMS_EPS);
            v2u* o8 = (v2u*)(O + (size_t)(m0 + r) * DM) + lane;
#pragma unroll
            for (int j = 0; j < 4; ++j) { v2u w; w.x = pk2(v[r][j].x * rstd * gv[j].x, v[r][j].y * rstd * gv[j].y); w.y = pk2(v[r][j].z * rstd * gv[j].z, v[r][j].w * rstd * gv[j].w); o8[64 * j] = w; }
        }
    }
}
__device__ __forceinline__ void final_norm_rows(const bf16* XR, const float* rowss, const float* g, float* out, int gtid, int nthreads) {
    for (int id = gtid; id < T * (DM / 8); id += nthreads) {
        const int row = id >> 7, c0 = (id & 127) * 8;
        const v4u w = *(const v4u*)(XR + (size_t)row * DM + c0);
        const float rs = 1.0f / sqrtf(rowss[row] * (1.0f / DM) + RMS_EPS);
        const f32x4 g0 = *(const f32x4*)(g + c0), g1 = *(const f32x4*)(g + c0 + 4);
        f32x4 o0, o1;
        o0.x = bflo(w.x) * rs * g0.x; o0.y = bfhi(w.x) * rs * g0.y; o0.z = bflo(w.y) * rs * g0.z; o0.w = bfhi(w.y) * rs * g0.w;
        o1.x = bflo(w.z) * rs * g1.x; o1.y = bfhi(w.z) * rs * g1.y; o1.z = bflo(w.w) * rs * g1.z; o1.w = bfhi(w.w) * rs * g1.w;
        *(f32x4*)(out + (size_t)row * DM + c0) = o0; *(f32x4*)(out + (size_t)row * DM + c0 + 4) = o1;
    }
}

__device__ __forceinline__ void ffn_fixup(const float* SIDE_U, const float* SIDE_G, const float* conv_w, const float* conv_b, bf16* ACT, int gtid, int nthreads) {
    constexpr int NCG = FFN / 8, NTASK = (T / 256) * 2 * NCG;
    for (int id = gtid; id < NTASK; id += nthreads) {
        const int cgp = id % NCG, r = (id / NCG) & 1, pm = id / (2 * NCG), c0 = cgp * 8;
        if ((pm & 7) == 0) continue;
        const float* A = SIDE_U + ((size_t)(pm - 1) * 4 + 2) * FFN + c0; const float* B = SIDE_U + ((size_t)(pm - 1) * 4 + 3) * FFN + c0;
        const float* C = SIDE_U + ((size_t)pm * 4 + 0) * FFN + c0; const float* D = SIDE_U + ((size_t)pm * 4 + 1) * FFN + c0;
        const float* pm2 = r ? B : A; const float* pm1 = r ? C : B; const float* pu = r ? D : C; const float* pg = SIDE_G + ((size_t)pm * 2 + r) * FFN + c0;
        float o[8];
#pragma unroll
        for (int h = 0; h < 2; ++h) {
            const f32x4 w0 = *(const f32x4*)(conv_w + c0 + 4 * h), w1 = *(const f32x4*)(conv_w + FFN + c0 + 4 * h), w2 = *(const f32x4*)(conv_w + 2 * FFN + c0 + 4 * h), cb = *(const f32x4*)(conv_b + c0 + 4 * h);
            const f32x4 um2 = *(const f32x4*)(pm2 + 4 * h), um1 = *(const f32x4*)(pm1 + 4 * h), u = *(const f32x4*)(pu + 4 * h), g = *(const f32x4*)(pg + 4 * h);
#pragma unroll
            for (int e = 0; e < 4; ++e) o[4 * h + e] = gelu_tanh(w0[e] * um2[e] + w1[e] * um1[e] + w2[e] * u[e] + cb[e]) * g[e];
        }
        v4u w; w.x = pk2(o[0], o[1]); w.y = pk2(o[2], o[3]); w.z = pk2(o[4], o[5]); w.w = pk2(o[6], o[7]);
        *(v4u*)(ACT + ((size_t)pm * 256 + r) * FFN + c0) = w;
    }
}

__device__ __forceinline__ void transpose_tile64(const bf16* src, int sld, bf16* dst, int dld, LAS bf16* scr, int lane) {
#pragma unroll
    for (int k = 0; k < 8; ++k) { const int id = lane + 64 * k, row = id >> 3, ch = id & 7; const v4u v = *(const v4u*)(src + (size_t)row * sld + ch * 8);
        LAS unsigned* w = (LAS unsigned*)(scr + row * 66 + ch * 8); w[0] = v.x; w[1] = v.y; w[2] = v.z; w[3] = v.w; }
    LDS_WAIT(); asm volatile("" ::: "memory");
#pragma unroll
    for (int k = 0; k < 8; ++k) { const int col = (lane >> 3) + 8 * k, tc = lane & 7; unsigned short s[8];
#pragma unroll
        for (int j = 0; j < 8; ++j) s[j] = scr[(8 * tc + j) * 66 + col];
        v4u o; o.x = (unsigned)s[0] | ((unsigned)s[1] << 16); o.y = (unsigned)s[2] | ((unsigned)s[3] << 16); o.z = (unsigned)s[4] | ((unsigned)s[5] << 16); o.w = (unsigned)s[6] | ((unsigned)s[7] << 16);
        *(v4u*)(dst + (size_t)col * dld + 8 * tc) = o; }
    LDS_WAIT(); asm volatile("" ::: "memory");
}

__device__ __forceinline__ void compress_unit(int kv, int b, int h, const bf16* P, const bf16* W1T, const float* c1, const bf16* W2T, bf16* outp, LAS unsigned char* lds, int wave, int lane) {
    const int r32 = lane & 31, g = lane >> 5;
    {
        const int nt = wave >> 1, jh = wave & 1, tid = wave * 64 + lane;
        constexpr int CB = 36864, CA0 = 0, CW0 = 18432;
        const bf16* abase = P + (size_t)(b * SEQ) * PLD + (kv ? COL_VC : COL_KC) + h * 64;
        v4u ra[2], rw[2];
#define CMP_LOAD(pos_) do { _Pragma("unroll") for (int k_ = 0; k_ < 2; ++k_) { const int id_ = tid + 512 * k_, row_ = id_ >> 3, ch_ = id_ & 7; int tok_ = 16 * row_ + (pos_); tok_ = tok_ > SEQ - 1 ? SEQ - 1 : tok_; \
            ra[k_] = *(const v4u*)(abase + (size_t)tok_ * PLD + 8 * ch_); rw[k_] = *(const v4u*)(W1T + (size_t)row_ * 2048 + (pos_) * 64 + 8 * ch_); } } while (0)
#define CMP_STORE(buf_) do { _Pragma("unroll") for (int k_ = 0; k_ < 2; ++k_) { const int id_ = tid + 512 * k_, row_ = id_ >> 3, ch_ = id_ & 7; \
            *(LAS v4u*)(lds + (buf_) * CB + CA0 + row_ * 144 + ch_ * 16) = ra[k_]; *(LAS v4u*)(lds + (buf_) * CB + CW0 + row_ * 144 + ch_ * 16) = rw[k_]; } } while (0)
        CMP_LOAD(0); CMP_STORE(0);
        __syncthreads();
        CMP_LOAD(1);
        f32x16 acc0 = zero16(), acc1 = zero16();
#pragma unroll 1
        for (int pos = 0; pos < 32; ++pos) {
            const LAS unsigned char* Ab = lds + (pos & 1) * CB + CA0; const LAS unsigned char* Wb = lds + (pos & 1) * CB + CW0;
            bf16x8 af[4], w0f[4], w1f[4];
#pragma unroll
            for (int sd = 0; sd < 4; ++sd) { af[sd] = *(const LAS bf16x8*)(Ab + (32 * nt + r32) * 144 + (16 * sd + 8 * g) * 2);
                w0f[sd] = *(const LAS bf16x8*)(Wb + (64 * jh + r32) * 144 + (16 * sd + 8 * g) * 2); w1f[sd] = *(const LAS bf16x8*)(Wb + (64 * jh + 32 + r32) * 144 + (16 * sd + 8 * g) * 2); }
#pragma unroll
            for (int sd = 0; sd < 4; ++sd) { acc0 = MFMA32(af[sd], w0f[sd], acc0); acc1 = MFMA32(af[sd], w1f[sd], acc1); }
            if (pos + 1 < 32) CMP_STORE((pos + 1) & 1);
            __syncthreads();
            if (pos + 2 < 32) CMP_LOAD(pos + 2);
        }
#undef CMP_LOAD
#undef CMP_STORE
        LAS bf16* G = (LAS bf16*)(lds + 73728);
#pragma unroll
        for (int jt = 0; jt < 2; ++jt) { const int j = 64 * jh + 32 * jt + r32; const float cj = c1[j];
#pragma unroll
            for (int r = 0; r < 16; ++r) { const int nn = 32 * nt + crow(r, g); const float v = gelu_tanh((jt ? acc1[r] : acc0[r]) + cj); G[nn * 136 + j] = (bf16)f2bf(v); } }
    }
    __syncthreads();
    {
        const int nt2 = wave >> 1, et = wave & 1;
        f32x16 acc = zero16();
#pragma unroll
        for (int s = 0; s < 8; ++s) {
            const bf16x8 gf = *(const LAS bf16x8*)(lds + 73728 + ((32 * nt2 + r32) * 136 + 16 * s + 8 * g) * 2);
            const bf16x8 wf = *(const bf16x8*)(W2T + (32 * et + r32) * 128 + 16 * s + 8 * g);
            acc = kv ? MFMA32(wf, gf, acc) : MFMA32(gf, wf, acc);
        }
        if (!kv) {
            bf16* o = outp + (size_t)(b * 2 + h) * 128 * 64;
#pragma unroll
            for (int r = 0; r < 16; ++r) { const int n = 32 * nt2 + crow(r, g), e = 32 * et + r32; o[n * 64 + e] = (n == 127) ? (bf16)0 : (bf16)f2bf(acc[r]); }
        } else {
            bf16* o = outp + (size_t)(b * 2 + h) * 64 * 128;
#pragma unroll
            for (int r = 0; r < 16; ++r) { const int e = 32 * et + crow(r, g), n = 32 * nt2 + r32; o[e * 128 + n] = (n == 127) ? (bf16)0 : (bf16)f2bf(acc[r]); }
        }
    }
    __syncthreads();
}

template <int CTRL> __device__ __forceinline__ float dppf(float v) { return __builtin_bit_cast(float, __builtin_amdgcn_update_dpp(0, __builtin_bit_cast(int, v), CTRL, 0xF, 0xF, false)); }
constexpr int GS_TOT = 0, GS_QD = 2048, GS_KD = 11264, GS_KST = 20480, GS_VT = 29696, GS_ATT = 48128, GS_SSQ = 52736, GS_DEC = 53248,
              GS_RA = 53504, GS_RQ = 55552, GS_RK = 63744, GS_RV = 71936, GS_XL = 88320;
struct GlaPre { v4u a, q, k, v0, v1, r; };
__device__ __forceinline__ void gla_prefetch(GlaPre& pf, const bf16* base, int h, int ith, int tid) {
    if (tid < 256) pf.a = *(const v4u*)(base + (size_t)(32 * ((tid >> 6) >> 1) + (tid & 31)) * PLD + COL_ALPHA + 8 * ((tid >> 5) & 1));
    const bf16* rp = base + (size_t)(tid >> 3) * PLD + h * 64 + 8 * (tid & 7);
    pf.k = *(const v4u*)(rp + COL_KB); pf.q = *(const v4u*)(rp + COL_QB);
    const bf16* vp0 = base + (size_t)(tid >> 4) * PLD + h * 128 + 8 * (tid & 15);
    pf.v0 = *(const v4u*)(vp0 + COL_VB); pf.v1 = *(const v4u*)(vp0 + (size_t)32 * PLD + COL_VB);
    pf.r = *(const v4u*)(vp0 + (size_t)(32 * ith) * PLD + COL_RB);
}
__device__ __forceinline__ void gla_seq(int item, const bf16* P, const float* w_alpha2, const float* b_alpha, const float* norm_g, bf16* OGLA, LAS unsigned char* lds, int tid, int wave, int lane) {
    const int b = item >> 3, h = (item >> 1) & 3, ith = item & 1;
    const int d = tid & 63, r32 = lane & 31, g = lane >> 5, et = wave & 3;
    LAS float* TOT = (LAS float*)(lds + GS_TOT); LAS float* SSQ = (LAS float*)(lds + GS_SSQ); LAS float* DECL = (LAS float*)(lds + GS_DEC);
    LAS bf16* QD = (LAS bf16*)(lds + GS_QD); LAS bf16* KD = (LAS bf16*)(lds + GS_KD); LAS bf16* KST = (LAS bf16*)(lds + GS_KST); LAS bf16* VT = (LAS bf16*)(lds + GS_VT); LAS bf16* ATT = (LAS bf16*)(lds + GS_ATT);
    LAS bf16* RQ = (LAS bf16*)(lds + GS_RQ); LAS bf16* RK = (LAS bf16*)(lds + GS_RK); LAS bf16* RV = (LAS bf16*)(lds + GS_RV);
    const bf16* Pb = P + (size_t)b * SEQ * PLD;
    bf16x8 w2f; float biasc;
    {   float wv[8]; const int col = 32 * (wave & 1) + r32;
#pragma unroll
        for (int j = 0; j < 8; ++j) wv[j] = w_alpha2[(8 * g + j) * 256 + h * 64 + col];
        w2f = pack8(wv); biasc = b_alpha[h * 64 + col]; }
    LAS float* XL = (LAS float*)(lds + GS_XL);
    float g8[8];
#pragma unroll
    for (int k = 0; k < 8; ++k) g8[k] = norm_g[8 * (tid & 15) + k];
    LAS float* OB = (LAS float*)(lds + GS_RQ);
    f32x16 S0 = zero16(), S1 = zero16();
    GlaPre pf; gla_prefetch(pf, Pb, h, ith, tid);
#pragma unroll 1
    for (int n = 0; n < 32; ++n) {
        const size_t row0 = (size_t)b * SEQ + 64 * n;
        if (wave < 4) {
            const f32x16 xg = MFMA32(__builtin_bit_cast(bf16x8, pf.a), w2f, zero16());
#pragma unroll
            for (int r = 0; r < 16; ++r) XL[(32 * (wave >> 1) + crow(r, g)) * 64 + 32 * (wave & 1) + r32] = xg[r] + biasc;
        }
        *(LAS v4u*)(lds + GS_RK + tid * 16) = pf.k; *(LAS v4u*)(lds + GS_RQ + tid * 16) = pf.q;
        *(LAS v4u*)(lds + GS_RV + tid * 16) = pf.v0; *(LAS v4u*)(lds + GS_RV + 8192 + tid * 16) = pf.v1;
        const v4u rcur = pf.r;
        if (n + 1 < 32) gla_prefetch(pf, Pb + (size_t)(64 * (n + 1)) * PLD, h, ith, tid);
        __syncthreads();
        float c[8];
        {
            float run = 0.f;
#pragma unroll
            for (int k = 0; k < 8; ++k) {
                const float x = XL[(8 * wave + k) * 64 + d];
                const float ls = fminf(x, 0.f) - __logf(1.0f + __expf(-fabsf(x)));
                run += ls * (1.0f / 16.0f); c[k] = run;
            }
            TOT[wave * 64 + d] = run;
        }
        __syncthreads();
        {
            float off = 0.f, blast = 0.f;
#pragma unroll
            for (int w = 0; w < 8; ++w) { const float tv = TOT[w * 64 + d]; blast += tv; off += (w < wave) ? tv : 0.f; }
            float ks[8];
#pragma unroll
            for (int k = 0; k < 8; ++k) {
                const int tok = 8 * wave + k; const float bk = off + c[k];
                const float kvv = bf2f(RK[tok * 64 + d]), qv = bf2f(RQ[tok * 64 + d]);
                QD[tok * 72 + d] = (bf16)f2bf(qv * __expf(bk)); KD[tok * 72 + d] = (bf16)f2bf(kvv * __expf(-bk));
                ks[k] = kvv * __expf(blast - bk);
            }
            *(LAS bf16x8*)(KST + d * 72 + 8 * wave) = pack8(ks);
            if (wave == 0) DECL[d] = __expf(blast);
            const int e = tid & 127, tg = tid >> 7;
            unsigned short vv[16];
#pragma unroll
            for (int k = 0; k < 16; ++k) vv[k] = RV[(16 * tg + k) * 128 + e];
            v4u w0, w1;
#pragma unroll
            for (int k = 0; k < 4; ++k) { w0[k] = (unsigned)vv[2 * k] | ((unsigned)vv[2 * k + 1] << 16); w1[k] = (unsigned)vv[8 + 2 * k] | ((unsigned)vv[8 + 2 * k + 1] << 16); }
            *(LAS v4u*)(VT + e * 72 + 16 * tg) = w0; *(LAS v4u*)(VT + e * 72 + 16 * tg + 8) = w1;
        }
        __syncthreads();
        f32x16 o = zero16();
        if (wave < 4) {
#pragma unroll
            for (int dt = 0; dt < 2; ++dt)
#pragma unroll
                for (int sp = 0; sp < 2; ++sp) {
                    float pp[8];
#pragma unroll
                    for (int j = 0; j < 8; ++j) pp[j] = dt ? S1[8 * sp + j] : S0[8 * sp + j];
                    const bf16x8 sb = pack8(pp);
                    const LAS bf16* qrow = QD + (32 * ith + r32) * 72 + 32 * dt + 16 * sp + 4 * g;
                    const v2u lo = *(const LAS v2u*)qrow, hi = *(const LAS v2u*)(qrow + 8);
                    v4u w; w.x = lo.x; w.y = lo.y; w.z = hi.x; w.w = hi.y;
                    o = MFMA32(__builtin_bit_cast(bf16x8, w), sb, o);
                }
#pragma unroll
            for (int r = 0; r < 16; ++r) { S0[r] *= DECL[crow(r, g)]; S1[r] *= DECL[32 + crow(r, g)]; }
#pragma unroll
            for (int s = 0; s < 4; ++s) {
                const bf16x8 vb = *(const LAS bf16x8*)(VT + (32 * et + r32) * 72 + 16 * s + 8 * g);
                const bf16x8 k0 = *(const LAS bf16x8*)(KST + r32 * 72 + 16 * s + 8 * g), k1 = *(const LAS bf16x8*)(KST + (32 + r32) * 72 + 16 * s + 8 * g);
                S0 = MFMA32(k0, vb, S0); S1 = MFMA32(k1, vb, S1);
            }
        } else if (wave < 6) {
            const int jt = wave - 4;
            f32x16 acc = zero16();
            if (jt <= ith) {
#pragma unroll
                for (int s = 0; s < 4; ++s) {
                    const bf16x8 a = *(const LAS bf16x8*)(QD + (32 * ith + r32) * 72 + 16 * s + 8 * g);
                    const bf16x8 bb = *(const LAS bf16x8*)(KD + (32 * jt + r32) * 72 + 16 * s + 8 * g);
                    acc = MFMA32(a, bb, acc);
                }
            }
#pragma unroll
            for (int r = 0; r < 16; ++r) { const int il = crow(r, g), j = 32 * jt + r32; ATT[il * 72 + j] = (bf16)f2bf(j <= 32 * ith + il ? acc[r] : 0.f); }
        }
        __syncthreads();
        if (wave < 4) {
#pragma unroll
            for (int s = 0; s < 4; ++s) {
                const bf16x8 a = *(const LAS bf16x8*)(ATT + r32 * 72 + 16 * s + 8 * g);
                const bf16x8 bb = *(const LAS bf16x8*)(VT + (32 * et + r32) * 72 + 16 * s + 8 * g);
                o = MFMA32(a, bb, o);
            }
#pragma unroll
            for (int r = 0; r < 16; ++r) OB[crow(r, g) * 128 + 32 * et + r32] = o[r];
        }
        __syncthreads();
        {
            const int rowl = tid >> 4, c8 = 8 * (tid & 15);
            const f32x4 x0 = *(const LAS f32x4*)(OB + rowl * 128 + c8), x1 = *(const LAS f32x4*)(OB + rowl * 128 + c8 + 4);
            float ss = (x0[0] * x0[0] + x0[1] * x0[1]) + (x0[2] * x0[2] + x0[3] * x0[3]) + (x1[0] * x1[0] + x1[1] * x1[1]) + (x1[2] * x1[2] + x1[3] * x1[3]);
            ss += dppf<0xB1>(ss); ss += dppf<0x4E>(ss); ss += dppf<0x124>(ss); ss += dppf<0x128>(ss);
            const float rstd = __builtin_amdgcn_rsqf(ss * (1.0f / 128.0f) + RMS_EPS);
            float ov[8];
#pragma unroll
            for (int k = 0; k < 4; ++k) { const float r0 = bflo(rcur[k]), r1 = bfhi(rcur[k]);
                ov[2 * k] = (k < 2 ? x0[2 * k] : x1[2 * k - 4]) * rstd * g8[2 * k] * (r0 * sigmoid_f(r0));
                ov[2 * k + 1] = (k < 2 ? x0[2 * k + 1] : x1[2 * k - 3]) * rstd * g8[2 * k + 1] * (r1 * sigmoid_f(r1)); }
            *(bf16x8*)(OGLA + (row0 + 32 * ith + rowl) * 512 + h * 128 + c8) = pack8(ov);
        }
        __syncthreads();
    }
}


template <int D> struct FlashState { f32x16 o[D / 32]; float m, l; };
template <int D> __device__ __forceinline__ void flash_reset(FlashState<D>& st) {
#pragma unroll
    for (int t = 0; t < D / 32; ++t) st.o[t] = zero16();
    st.m = -1e30f; st.l = 0.f;
}
__device__ __forceinline__ void half_swap(float x, float& a, float& b) { unsigned ua = __builtin_bit_cast(unsigned, x), ub = ua;
    asm("s_nop 1\n\tv_permlane32_swap_b32 %0, %1\n\ts_nop 1" : "+v"(ua), "+v"(ub)); a = __builtin_bit_cast(float, ua); b = __builtin_bit_cast(float, ub); }
__device__ __forceinline__ float xmax32(float x) { float a, b; half_swap(x, a, b); return fmaxf(a, b); }
__device__ __forceinline__ float xsum32(float x) { float a, b; half_swap(x, a, b); return a + b; }
__device__ __forceinline__ float xoth32(float x, int g) { float a, b; half_swap(x, a, b); return g ? a : b; }
template <int D>
__device__ __forceinline__ void flash_tile_fast(FlashState<D>& st, const bf16x8 (&qf)[D / 16], const LAS unsigned char* Kt, int pk, const LAS unsigned char* Vt, int pv, float slope2, float c0, int lane) {
    const int r32 = lane & 31, g = lane >> 5;
    f32x16 s0, s1;
#pragma unroll
    for (int r = 0; r < 16; ++r) { const float kc = (float)((r & 3) + 8 * (r >> 2)); s0[r] = __builtin_fmaf(slope2, kc, c0); s1[r] = __builtin_fmaf(slope2, kc + 32.0f, c0); }
#pragma unroll
    for (int sb = 0; sb < D / 64; ++sb) {
        bf16x8 kf[8];
#pragma unroll
        for (int s = 0; s < 4; ++s) { kf[2 * s] = *(const LAS bf16x8*)(Kt + r32 * pk + (16 * (4 * sb + s) + 8 * g) * 2); kf[2 * s + 1] = *(const LAS bf16x8*)(Kt + (32 + r32) * pk + (16 * (4 * sb + s) + 8 * g) * 2); }
        asm volatile("" :: "v"(kf[0]), "v"(kf[1]), "v"(kf[2]), "v"(kf[3]), "v"(kf[4]), "v"(kf[5]), "v"(kf[6]), "v"(kf[7]));
#pragma unroll
        for (int s = 0; s < 4; ++s) { s0 = MFMA32(kf[2 * s], qf[4 * sb + s], s0); s1 = MFMA32(kf[2 * s + 1], qf[4 * sb + s], s1); }
    }
    v4u vf[2][2][D / 32];
#pragma unroll
    for (int kh = 0; kh < 2; ++kh)
#pragma unroll
        for (int sp = 0; sp < 2; ++sp)
#pragma unroll
            for (int t = 0; t < D / 32; ++t) {
                const LAS unsigned char* vrow = Vt + (32 * t + r32) * pv + (32 * kh + 16 * sp + 4 * g) * 2;
                const v2u lo = *(const LAS v2u*)vrow, hi = *(const LAS v2u*)(vrow + 16);
                vf[kh][sp][t].x = lo.x; vf[kh][sp][t].y = lo.y; vf[kh][sp][t].z = hi.x; vf[kh][sp][t].w = hi.y;
            }
    __builtin_amdgcn_sched_barrier(0);
    float mx = -1e30f;
#pragma unroll
    for (int r = 0; r < 16; ++r) mx = fmaxf(mx, fmaxf(s0[r], s1[r]));
    mx = xmax32(mx);
    const float mn = fmaxf(st.m, mx);
    if (__ballot(mn > st.m) != 0ull) { const float alpha = ex2(st.m - mn); st.l *= alpha;
#pragma unroll
        for (int t = 0; t < D / 32; ++t) st.o[t] = st.o[t] * alpha; }
    st.m = mn;
    float sum = 0.f;
#pragma unroll
    for (int r = 0; r < 16; ++r) { const float p0 = ex2(s0[r] - mn), p1 = ex2(s1[r] - mn); s0[r] = p0; s1[r] = p1; sum += p0 + p1; }
    st.l += sum;
#pragma unroll
    for (int kh = 0; kh < 2; ++kh)
#pragma unroll
        for (int sp = 0; sp < 2; ++sp) {
            float pp[8];
#pragma unroll
            for (int j = 0; j < 8; ++j) pp[j] = kh ? s1[8 * sp + j] : s0[8 * sp + j];
            const bf16x8 pb = pack8(pp);
#pragma unroll
            for (int t = 0; t < D / 32; ++t) st.o[t] = MFMA32(__builtin_bit_cast(bf16x8, vf[kh][sp][t]), pb, st.o[t]);
        }
}
template <int D, class F>
__device__ __forceinline__ void flash_tile(FlashState<D>& st, const bf16x8 (&qf)[D / 16], const LAS unsigned char* Kt, int pk, const LAS unsigned char* Vt, int pv, const F& f, int lane) {
    const int r32 = lane & 31, g = lane >> 5;
    f32x16 s0 = zero16(), s1 = zero16();
#pragma unroll
    for (int sb = 0; sb < D / 64; ++sb) {
        bf16x8 kf[8];
#pragma unroll
        for (int s = 0; s < 4; ++s) { kf[2 * s] = *(const LAS bf16x8*)(Kt + r32 * pk + (16 * (4 * sb + s) + 8 * g) * 2); kf[2 * s + 1] = *(const LAS bf16x8*)(Kt + (32 + r32) * pk + (16 * (4 * sb + s) + 8 * g) * 2); }
        asm volatile("" :: "v"(kf[0]), "v"(kf[1]), "v"(kf[2]), "v"(kf[3]), "v"(kf[4]), "v"(kf[5]), "v"(kf[6]), "v"(kf[7]));
#pragma unroll
        for (int s = 0; s < 4; ++s) { s0 = MFMA32(kf[2 * s], qf[4 * sb + s], s0); s1 = MFMA32(kf[2 * s + 1], qf[4 * sb + s], s1); }
    }
    float mx = -1e30f;
#pragma unroll
    for (int r = 0; r < 16; ++r) { bool v0, v1; const float x0 = f(s0[r], crow(r, g), v0), x1 = f(s1[r], 32 + crow(r, g), v1);
        s0[r] = v0 ? x0 : -1e30f; s1[r] = v1 ? x1 : -1e30f; mx = fmaxf(mx, fmaxf(s0[r], s1[r])); }
    mx = xmax32(mx);
    const float mn = fmaxf(st.m, mx), alpha = ex2(st.m - mn);
    float sum = 0.f;
#pragma unroll
    for (int r = 0; r < 16; ++r) { const float p0 = s0[r] > -1e29f ? ex2(s0[r] - mn) : 0.f, p1 = s1[r] > -1e29f ? ex2(s1[r] - mn) : 0.f; s0[r] = p0; s1[r] = p1; sum += p0 + p1; }
    st.l = st.l * alpha + sum; st.m = mn;
#pragma unroll
    for (int t = 0; t < D / 32; ++t) st.o[t] = st.o[t] * alpha;
#pragma unroll
    for (int kh = 0; kh < 2; ++kh) {
        v4u vf[2][D / 32];
#pragma unroll
        for (int sp = 0; sp < 2; ++sp)
#pragma unroll
            for (int t = 0; t < D / 32; ++t) {
                const LAS unsigned char* vrow = Vt + (32 * t + r32) * pv + (32 * kh + 16 * sp + 4 * g) * 2;
                const v2u lo = *(const LAS v2u*)vrow, hi = *(const LAS v2u*)(vrow + 16);
                vf[sp][t].x = lo.x; vf[sp][t].y = lo.y; vf[sp][t].z = hi.x; vf[sp][t].w = hi.y;
            }
#pragma unroll
        for (int sp = 0; sp < 2; ++sp)
#pragma unroll
            for (int t = 0; t < D / 32; ++t) asm volatile("" :: "v"(vf[sp][t]));
#pragma unroll
        for (int sp = 0; sp < 2; ++sp) {
            float pp[8];
#pragma unroll
            for (int j = 0; j < 8; ++j) pp[j] = kh ? s1[8 * sp + j] : s0[8 * sp + j];
            const bf16x8 pb = pack8(pp);
#pragma unroll
            for (int t = 0; t < D / 32; ++t) st.o[t] = MFMA32(__builtin_bit_cast(bf16x8, vf[sp][t]), pb, st.o[t]);
        }
    }
}

constexpr int NS_KB = 0, NS_VB = 18432, NS_CK = 36864, NS_CV = 55296, NS_OA = 72704, NS_US = 138240;
struct MaskF { int tq, kbase, selbit, wlim; float slope2;
    __device__ __forceinline__ float operator()(float s, int key, bool& valid) const { const int dist = tq - (kbase + key); valid = selbit && dist >= 0 && dist < wlim; return s - slope2 * (float)dist; } };
struct NoF { __device__ __forceinline__ float operator()(float s, int, bool& valid) const { valid = true; return s; } };

__device__ __forceinline__ void nsa_unit(int b, int h, int i, const bf16* P, const float* gate_b, const bf16* KCMP, const bf16* VCMPT, const bf16* VST, const bf16* VWT, bf16* ONSA,
                                         LAS unsigned char* lds, int tid, int wave, int lane) {
    const int r32 = lane & 31, g = lane >> 5, ql = r32 >> 2, gq = r32 & 3, hq = 4 * h + gq;
    const int tq = 64 * i + 8 * wave + ql;
    const size_t row = (size_t)b * SEQ + tq;
    bf16x8 qf[4];
#pragma unroll
    for (int s = 0; s < 4; ++s) qf[s] = *(const bf16x8*)(P + row * PLD + COL_QA + hq * 64 + 16 * s + 8 * g);
    float gate[3];
#pragma unroll
    for (int k = 0; k < 3; ++k) gate[k] = sigmoid_f(bf2f(P[row * PLD + COL_GATE + hq * 3 + k]) + gate_b[hq * 3 + k]);
    const float slope2 = ex2(-(float)(hq + 1)) * LOG2E;
    const bf16* Kslc = P + (size_t)b * SEQ * PLD + COL_KS + h * 64; const bf16* Kwin = P + (size_t)b * SEQ * PLD + COL_KW + h * 64;
    const bf16* Vslc = VST + (size_t)(b * 2 + h) * 64 * SEQ; const bf16* Vwin = VWT + (size_t)(b * 2 + h) * 64 * SEQ;
    const int jw0 = i > 4 ? i - 4 : 0;
    const int srow = tid >> 3, sch = tid & 7;
#define NS_LOAD(td, rk, rv) do { const int td_ = (td); const bool w_ = (td_ >> 8) != 0; const int j_ = td_ & 255; \
        rk = *(const v4u*)((w_ ? Kwin : Kslc) + (size_t)(64 * j_ + srow) * PLD + 8 * sch); rv = *(const v4u*)((w_ ? Vwin : Vslc) + (size_t)srow * SEQ + 64 * j_ + 8 * sch); } while (0)
#define NS_STORE(buf, rk, rv) do { *(LAS v4u*)(lds + NS_KB + (buf) * 9216 + srow * 144 + sch * 16) = rk; *(LAS v4u*)(lds + NS_VB + (buf) * 9216 + srow * 144 + sch * 16) = rv; } while (0)
#define NS_NEXT(rem, wj, td) do { if (rem) { const int j_ = 31 - __builtin_clz(rem); rem &= ~(1u << j_); td = j_; } else if (wj >= jw0) { td = wj | 256; --wj; } else td = -1; } while (0)
    v4u rk, rv;
    NS_LOAD(i, rk, rv);
    LAS unsigned* usel_w = (LAS unsigned*)(lds + NS_US);
    if (tid == 0) *usel_w = 0u;
    {
        const bf16* kc = KCMP + (size_t)(b * 2 + h) * 128 * 64; const bf16* vc = VCMPT + (size_t)(b * 2 + h) * 64 * 128;
#pragma unroll
        for (int k = 0; k < 2; ++k) { const int id = tid + 512 * k;
            *(LAS v4u*)(lds + NS_CK + (id >> 3) * 144 + (id & 7) * 16) = *(const v4u*)(kc + (size_t)(id >> 3) * 64 + 8 * (id & 7));
            *(LAS v4u*)(lds + NS_CV + (id >> 4) * 272 + (id & 15) * 16) = *(const v4u*)(vc + (size_t)(id >> 4) * 128 + 8 * (id & 15)); }
    }
    NS_STORE(0, rk, rv);
    __syncthreads();
    LAS float* oa = (LAS float*)(lds + NS_OA + wave * 8192) + lane;
    unsigned sel;
    {
        f32x16 S[4];
#pragma unroll
        for (int kh = 0; kh < 4; ++kh) { S[kh] = zero16();
            if (32 * kh <= 4 * i + 2) {
                bf16x8 kf[4];
#pragma unroll
                for (int s = 0; s < 4; ++s) kf[s] = *(const LAS bf16x8*)(lds + NS_CK + (32 * kh + r32) * 144 + (16 * s + 8 * g) * 2);
                asm volatile("" :: "v"(kf[0]), "v"(kf[1]), "v"(kf[2]), "v"(kf[3]));
#pragma unroll
                for (int s = 0; s < 4; ++s) S[kh] = MFMA32(kf[s], qf[s], S[kh]); } }
        float mx = -1e30f;
#pragma unroll
        for (int kh = 0; kh < 4; ++kh) if (32 * kh <= 4 * i + 2) {
#pragma unroll
            for (int r = 0; r < 16; ++r) { const int n = 32 * kh + crow(r, g), dist = tq - (16 * n + 31); const float x = S[kh][r] - slope2 * (float)dist;
                S[kh][r] = dist >= 0 ? x : -1e30f; mx = fmaxf(mx, S[kh][r]); } }
        mx = xmax32(mx);
        float lsum = 0.f;
#pragma unroll
        for (int kh = 0; kh < 4; ++kh) if (32 * kh <= 4 * i + 2) {
#pragma unroll
            for (int r = 0; r < 16; ++r) { const float e = S[kh][r] > -1e29f ? ex2(S[kh][r] - mx) : 0.f; S[kh][r] = e; lsum += e; } }
        lsum = xsum32(lsum);
        const float inv = lsum > 0.f ? 1.0f / lsum : 0.f;
#pragma unroll
        for (int kh = 0; kh < 4; ++kh) S[kh] = S[kh] * inv;
        float A[16], C[16];
#pragma unroll
        for (int kh = 0; kh < 4; ++kh)
#pragma unroll
            for (int m = 0; m < 4; ++m) { const float p3 = S[kh][4 * m + 3]; A[4 * kh + m] = (S[kh][4 * m] + S[kh][4 * m + 1]) + (S[kh][4 * m + 2] + 0.5f * p3); C[4 * kh + m] = 0.5f * p3; }
        f32x16 O[2]; O[0] = zero16(); O[1] = zero16();
#pragma unroll
        for (int kh = 0; kh < 4; ++kh) if (32 * kh <= 4 * i + 2)
#pragma unroll
            for (int sp = 0; sp < 2; ++sp) { float pp[8];
#pragma unroll
                for (int j = 0; j < 8; ++j) pp[j] = S[kh][8 * sp + j];
                const bf16x8 pb = pack8(pp);
                v4u vf[2];
#pragma unroll
                for (int t = 0; t < 2; ++t) { const LAS unsigned char* vrow = lds + NS_CV + (32 * t + r32) * 272 + (32 * kh + 16 * sp + 4 * g) * 2;
                    const v2u lo = *(const LAS v2u*)vrow, hi = *(const LAS v2u*)(vrow + 16); vf[t].x = lo.x; vf[t].y = lo.y; vf[t].z = hi.x; vf[t].w = hi.y; }
                asm volatile("" :: "v"(vf[0]), "v"(vf[1]));
#pragma unroll
                for (int t = 0; t < 2; ++t) O[t] = MFMA32(__builtin_bit_cast(bf16x8, vf[t]), pb, O[t]); }
#pragma unroll
        for (int t = 0; t < 2; ++t)
#pragma unroll
            for (int r = 0; r < 16; ++r) oa[(16 * t + r) * 64] = O[t][r] * gate[0];
        __builtin_amdgcn_sched_barrier(0);
#pragma unroll
        for (int k = 0; k < 16; ++k) { A[k] += dppf<0xB1>(A[k]); A[k] += dppf<0x4E>(A[k]); C[k] += dppf<0xB1>(C[k]); C[k] += dppf<0x4E>(C[k]); }
        float own[16];
        {   float Co[16];
#pragma unroll
            for (int k = 0; k < 16; ++k) Co[k] = xoth32(C[k], g);
#pragma unroll
            for (int k = 0; k < 16; ++k) { const float prev = k > 0 ? Co[k - 1] : 0.f; own[k] = A[k] + (g ? Co[k] : prev); } }
        float imp[32];
#pragma unroll
        for (int k = 0; k < 16; ++k) { const float oth = xoth32(own[k], g); imp[2 * k] = g ? oth : own[k]; imp[2 * k + 1] = g ? own[k] : oth; }
        sel = 1u | (1u << i) | ((1u << i) >> 1);
        if (i < 8) sel = 0xffu;
        else {
            int key[32];
#pragma unroll
            for (int j = 0; j < 32; ++j) { const int kb = (int)((__builtin_bit_cast(unsigned, imp[j]) & ~31u) | (unsigned)(31 - j)); key[j] = (j >= 1 && j <= i - 2) ? kb : (int)0x80000000; }
#pragma unroll 1
            for (int it = 0; it < 5; ++it) {
                int b0 = key[0];
#pragma unroll
                for (int j = 1; j < 32; ++j) b0 = key[j] > b0 ? key[j] : b0;
                sel |= 1u << (31 - (b0 & 31));
#pragma unroll
                for (int j = 0; j < 32; ++j) key[j] = key[j] == b0 ? (int)0x80000000 : key[j];
            }
        }
        sel &= (i >= 31) ? 0xffffffffu : ((2u << i) - 1u);
    }
    {   unsigned u = sel;
#pragma unroll
        for (int o = 1; o < 64; o <<= 1) u |= (unsigned)__shfl_xor((int)u, o);
        if (lane == 0) __hip_atomic_fetch_or(usel_w, u, __ATOMIC_RELAXED, __HIP_MEMORY_SCOPE_WORKGROUP); }
    __syncthreads();
    unsigned rem = (unsigned)__builtin_amdgcn_readfirstlane((int)*usel_w);
    int wj = i, tdc, tdn, tdp;
    rem &= ~(1u << i); tdc = i;
    NS_NEXT(rem, wj, tdn);
    if (tdn >= 0) NS_LOAD(tdn, rk, rv);
    FlashState<64> st; flash_reset(st);
    bool in_win = false;
    for (int ts = 0; tdc >= 0; ++ts) {
        const bool w = (tdc >> 8) != 0; const int j = tdc & 255;
        if (w && !in_win) {
            in_win = true;
            const float lt = xsum32(st.l), sc = lt > 0.f ? gate[1] / lt : 0.f;
#pragma unroll
            for (int t = 0; t < 2; ++t)
#pragma unroll
                for (int r = 0; r < 16; ++r) oa[(16 * t + r) * 64] += st.o[t][r] * sc;
            flash_reset(st);
        }
        const LAS unsigned char* Kt = lds + NS_KB + (ts & 1) * 9216; const LAS unsigned char* Vt = lds + NS_VB + (ts & 1) * 9216;
        {
            const int selbit = w ? 1 : (int)((sel >> j) & 1u);
            if (__ballot(selbit) != 0ull) {
                if (j == i || (w && j == i - 4)) { const MaskF f{tq, 64 * j, selbit, w ? 256 : (1 << 30), slope2}; flash_tile<64>(st, qf, Kt, 144, Vt, 144, f, lane); }
                else {
                    flash_tile_fast<64>(st, qf, Kt, 144, Vt, 144, slope2, (selbit ? 0.f : -1e30f) - slope2 * (float)(tq - 64 * j - 4 * g), lane); }
            }
        }
        NS_NEXT(rem, wj, tdp);
        if (tdn >= 0) NS_STORE((ts + 1) & 1, rk, rv);
        __syncthreads();
        if (tdp >= 0) NS_LOAD(tdp, rk, rv);
        tdc = tdn; tdn = tdp;
    }
    {   const float lt = xsum32(st.l), sc = lt > 0.f ? gate[2] / lt : 0.f;
#pragma unroll
        for (int t = 0; t < 2; ++t)
#pragma unroll
            for (int r = 0; r < 16; ++r) st.o[t][r] = oa[(16 * t + r) * 64] + st.o[t][r] * sc; }
    bf16* op = ONSA + row * 512 + hq * 64 + 4 * g;
#pragma unroll
    for (int t = 0; t < 2; ++t)
#pragma unroll
        for (int rq = 0; rq < 4; ++rq) { v2u w; w.x = pk2(st.o[t][4 * rq], st.o[t][4 * rq + 1]); w.y = pk2(st.o[t][4 * rq + 2], st.o[t][4 * rq + 3]); *(v2u*)(op + 32 * t + 8 * rq) = w; }
#undef NS_LOAD
#undef NS_STORE
#undef NS_NEXT
}

constexpr int XA_K = 0, XA_V = 69632;
__device__ __forceinline__ void xattn_item(int item, const bf16* XQ, const bf16* MEMKV, const bf16* MEMVT, bf16* XO, LAS unsigned char* lds, int tid, int wave, int lane) {
    const int bh = item >> 1, half = item & 1, b = bh >> 2, h = bh & 3;
    const int r32 = lane & 31, g = lane >> 5;
    {
        const bf16* ks = MEMKV + (size_t)(b * MEM_LEN) * 1024 + h * 128; const bf16* vs = MEMVT + (size_t)bh * 128 * 256;
#pragma unroll
        for (int k = 0; k < 8; ++k) { const int id = tid + 512 * k;
            *(LAS v4u*)(lds + XA_K + (id >> 4) * 272 + (id & 15) * 16) = *(const v4u*)(ks + (size_t)(id >> 4) * 1024 + 8 * (id & 15));
            *(LAS v4u*)(lds + XA_V + (id >> 5) * 528 + (id & 31) * 16) = *(const v4u*)(vs + (size_t)(id >> 5) * 256 + 8 * (id & 31)); }
    }
    __syncthreads();
    for (int qt = 4 * half; qt < 4 * half + 4; ++qt) {
        const size_t row = (size_t)b * SEQ + 256 * qt + 32 * wave + r32;
        bf16x8 qf[8];
#pragma unroll
        for (int s = 0; s < 8; ++s) qf[s] = *(const bf16x8*)(XQ + row * 512 + h * 128 + 16 * s + 8 * g);
        FlashState<128> st; flash_reset(st);
        const NoF f{};
#pragma unroll 1
        for (int kt = 0; kt < 4; ++kt) flash_tile<128>(st, qf, lds + XA_K + kt * 64 * 272, 272, lds + XA_V + kt * 128, 528, f, lane);
        const float lt = xsum32(st.l), sc = 1.0f / lt;
        bf16* op = XO + row * 512 + h * 128 + 4 * g;
#pragma unroll
        for (int t = 0; t < 4; ++t)
#pragma unroll
            for (int rq = 0; rq < 4; ++rq) { v2u w; w.x = pk2(st.o[t][4 * rq] * sc, st.o[t][4 * rq + 1] * sc); w.y = pk2(st.o[t][4 * rq + 2] * sc, st.o[t][4 * rq + 3] * sc); *(v2u*)(op + 32 * t + 8 * rq) = w; }
    }
    __syncthreads();
}
#define XB_TMO      128
#define XB_XCNT(j)  (256  + 64 * (j))
#define XB_XSUB(j)  (1280 + 64 * (j))
#define XB_XGEN(j)  (2304 + 64 * (j))
#define XB_TOP      3328
#define XB_TOPGEN   3392
#define XCD_BAR_WORDS 3456
#define XB_SPIN_CAP (1u << 18)

__device__ __forceinline__ unsigned xb_ld(unsigned* p)              { return __hip_atomic_load(p, __ATOMIC_RELAXED, __HIP_MEMORY_SCOPE_AGENT); }
__device__ __forceinline__ unsigned xb_add(unsigned* p, unsigned v) { return __hip_atomic_fetch_add(p, v, __ATOMIC_RELAXED, __HIP_MEMORY_SCOPE_AGENT); }
__device__ __forceinline__ unsigned xb_xcc_id() { return (unsigned)__builtin_amdgcn_s_getreg((3 << 11) | 20) & 0xFu; }
#define XB_SPIN(cond, bar) do { unsigned _sp = 0; while (cond) { __builtin_amdgcn_s_sleep(1); \
    if ((++_sp & 255u) == 0u) { if (xb_ld(&(bar)[XB_TMO])) break; if (_sp > XB_SPIN_CAP) { atomicAdd(&(bar)[XB_TMO], 1u); break; } } } } while (0)

struct XcdBarrier {
    unsigned* bar; unsigned x;
    volatile LAS unsigned* st;
};

__device__ __forceinline__ XcdBarrier xcd_barrier_post(unsigned* bar, volatile LAS unsigned* st) {
    XcdBarrier b; b.bar = bar; b.x = xb_xcc_id(); b.st = st;
    if (threadIdx.x == 0) (void)xb_add(&bar[XB_XCNT(b.x)], 1u);
    return b;
}
__device__ __forceinline__ void xcd_barrier_complete(unsigned* bar, unsigned x, unsigned& nloc, unsigned& nx) {
    const unsigned G = gridDim.x * gridDim.y * gridDim.z;
    unsigned sum, cnt, mine, sp = 0u;
    for (;;) {
        sum = 0u; cnt = 0u; mine = 0u;
#pragma unroll
        for (unsigned j = 0; j < 16; ++j) { const unsigned c = xb_ld(&bar[XB_XCNT(j)]); sum += c; cnt += (c > 0u) ? 1u : 0u; mine = (j == x) ? c : mine; }
        if (sum == G) break;
        __builtin_amdgcn_s_sleep(1);
        if ((++sp & 255u) == 0u) { if (xb_ld(&bar[XB_TMO])) break; if (sp > XB_SPIN_CAP) { atomicAdd(&bar[XB_TMO], 1u); break; } }
    }
    nloc = mine > 0u ? mine : 1u; nx = cnt > 0u ? cnt : 1u;
}

__device__ __forceinline__ void xcd_barrier(const XcdBarrier& b) {
    asm volatile("s_waitcnt vmcnt(0)" ::: "memory");
    __syncthreads();
    if (threadIdx.x == 0) {
        unsigned* bar = b.bar;
        __builtin_amdgcn_s_waitcnt(0);
        unsigned nloc = b.st[0], nx = b.st[1];
        if (nloc == 0u) { xcd_barrier_complete(bar, b.x, nloc, nx); b.st[0] = nloc; b.st[1] = nx; }
        const unsigned old = xb_add(&bar[XB_XSUB(b.x)], 1u);
        const unsigned gen = old / nloc;
        if (old + 1u == (gen + 1u) * nloc) {
            __builtin_amdgcn_fence(__ATOMIC_RELEASE, "agent");
            asm volatile("s_waitcnt vmcnt(0)" ::: "memory");
            const unsigned og = xb_add(&bar[XB_TOP], 1u);
            const unsigned tg = og / nx;
            if (og + 1u == (tg + 1u) * nx) xb_add(&bar[XB_TOPGEN], 1u);
            else XB_SPIN(xb_ld(&bar[XB_TOPGEN]) == tg, bar);
            __builtin_amdgcn_fence(__ATOMIC_ACQUIRE, "agent");
            xb_add(&bar[XB_XGEN(b.x)], 1u);
            asm volatile("s_waitcnt vmcnt(0)" ::: "memory");
        } else {
            XB_SPIN(xb_ld(&bar[XB_XGEN(b.x)]) == gen, bar);
            __builtin_amdgcn_fence(__ATOMIC_ACQUIRE, "agent");
            asm volatile("s_waitcnt vmcnt(0)" ::: "memory");
        }
    }
    __syncthreads();
}

struct Args { const float* in[28]; float* out; unsigned char* ws; };
enum { I_X = 0, I_MEM, I_LN_MIX_G, I_W_IN, I_NSA_GATE_B, I_CMP_POS_K, I_CMP_W1_K, I_CMP_W2_K, I_CMP_POS_V, I_CMP_W1_V, I_CMP_W2_V, I_GLA_W_ALPHA2, I_GLA_B_ALPHA, I_GLA_NORM_G,
       I_W_BRANCH_NSA, I_W_BRANCH_GLA, I_W_OUT, I_LN_X_G, I_LN_MEM_G, I_W_XQ, I_W_XKV, I_W_XO, I_LN_FFN_G, I_W_UP, I_CONV_W, I_CONV_B, I_W_DOWN, I_LN_FINAL_G };


__global__ void __launch_bounds__(NTHREADS, 2) fwd_kernel(Args args) {
    extern __shared__ __attribute__((aligned(16))) unsigned char lds_raw[];
    cg::grid_group grid = cg::this_grid();
    LAS unsigned char* lds = (LAS unsigned char*)lds_raw;
    const int tid = threadIdx.x, lane = tid & 63, wave = __builtin_amdgcn_readfirstlane(tid >> 6);
    const int G = gridDim.x, bx = blockIdx.x;
    const int gw = bx * NWAVES + wave, NGW = G * NWAVES;
    const int gtid = bx * NTHREADS + tid, NTH = G * NTHREADS;
    unsigned char* ws = args.ws;
    bf16* WIN_T = (bf16*)(ws + WS_WIN); bf16* WUP_T = (bf16*)(ws + WS_WUP); bf16* WDOWN_T = (bf16*)(ws + WS_WDOWN); bf16* WXKV_T = (bf16*)(ws + WS_WXKV); bf16* WOUT_T = (bf16*)(ws + WS_WOUT);
    bf16* WBN_T = (bf16*)(ws + WS_WBN); bf16* WBG_T = (bf16*)(ws + WS_WBG); bf16* WXQ_T = (bf16*)(ws + WS_WXQ); bf16* WXO_T = (bf16*)(ws + WS_WXO);
    bf16* W1K_T = (bf16*)(ws + WS_W1K); bf16* W1V_T = (bf16*)(ws + WS_W1V); bf16* W2K_T = (bf16*)(ws + WS_W2K); bf16* W2V_T = (bf16*)(ws + WS_W2V); float* C1 = (float*)(ws + WS_C1);
    bf16* XN0 = (bf16*)(ws + WS_XN0); bf16* XN = (bf16*)(ws + WS_XN); bf16* VST = (bf16*)(ws + WS_VST); bf16* VWT = (bf16*)(ws + WS_VWT); bf16* KCMP = (bf16*)(ws + WS_KCMP); bf16* VCMPT = (bf16*)(ws + WS_VCMPT);
    bf16* MIX = (bf16*)(ws + WS_MIX);
    unsigned char* G8 = ws + WS_G8;
    bf16* P = (bf16*)(ws + WS_P); bf16* XQ = (bf16*)(ws + WS_XQ); bf16* XO = (bf16*)(ws + WS_XO); bf16* ACT = (bf16*)(ws + WS_ACT);
    bf16* MEMN = (bf16*)(ws + WS_MEMN); bf16* MEMKV = (bf16*)(ws + WS_MEMKV); bf16* ONSA = (bf16*)(ws + WS_ONSA); bf16* OGLA = (bf16*)(ws + WS_OGLA);
    bf16* MEMVT = (bf16*)(ws + WS_MEMVT2);
    float* SIDE_U = (float*)(ws + WS_SIDEU); float* SIDE_G = (float*)(ws + WS_SIDEG);
    float* ROWSS1 = (float*)(ws + WS_ROWSS); float* ROWSS2 = ROWSS1 + T; float* ROWSS3 = ROWSS2 + T;
    float* out = args.out;
    const float* x = args.in[I_X];
    if (tid < 16) ((LAS unsigned*)(lds + LDS_BYTES - 64))[tid] = 0u;
    __syncthreads();
    const XcdBarrier xbar = xcd_barrier_post((unsigned*)(ws + WS_CTL) + 4096, (volatile LAS unsigned*)(lds + LDS_BYTES - 64));
#define GRID_SYNC() xcd_barrier(xbar)

    {
        LAS float* scr = (LAS float*)(lds + wave * 16384);
        const float* w_in = args.in[I_W_IN];
        constexpr int J0 = 16 * 16, J1 = 16 * 24, J2 = 16 * 8, J3 = 16 * 40, J4 = 16 * 64;
        constexpr int J5 = 16 * 32, J6 = 8 * 32, J7 = 8 * 32, J8 = 16 * 32, J9 = 16 * 16, J10 = 8 * 32;
        constexpr int J11 = 16 * 176, J12 = 44 * 32;
        constexpr int J13 = 32 * 4, J14 = 32 * 4, J15 = 2 * 2, J16 = 2 * 2;
        constexpr int NITEMS = J0 + J1 + J2 + J3 + J4 + J5 + J6 + J7 + J8 + J9 + J10 + J11 + J12 + J13 + J14 + J15 + J16;
        for (int it = gw; it < NITEMS; it += NGW) {
            int r = it;
            if (r < J0) { transpose_item(w_in + 0, IN_W, DM, 512, WIN_T, COL_QA, 0.125f * LOG2E, scr, r, lane); continue; } r -= J0;
            if (r < J1) { transpose_item(w_in + 512, IN_W, DM, 768, WIN_T, COL_KC, 1.0f, scr, r, lane); continue; } r -= J1;
            if (r < J2) { transpose_item(w_in + 1304, IN_W, DM, 256, WIN_T, COL_QB, 0.125f, scr, r, lane); continue; } r -= J2;
            if (r < J3) { transpose_item(w_in + 1560, IN_W, DM, 1280, WIN_T, COL_KB, 1.0f, scr, r, lane); continue; } r -= J3;
            if (r < J4) { transpose_item(w_in + 2856, IN_W, DM, 2048, WIN_T, WROW_GN, 1.0f, scr, r, lane); continue; } r -= J4;
            if (r < J5) { transpose_item(args.in[I_W_XKV], 1024, DM, 1024, WXKV_T, 0, 1.0f, scr, r, lane); continue; } r -= J5;
            if (r < J6) { transpose_item(args.in[I_W_BRANCH_NSA], 1024, 512, 1024, WBN_T, 0, 1.0f, scr, r, lane); continue; } r -= J6;
            if (r < J7) { transpose_item(args.in[I_W_BRANCH_GLA], 1024, 512, 1024, WBG_T, 0, 1.0f, scr, r, lane); continue; } r -= J7;
            if (r < J8) { transpose_item(args.in[I_W_OUT], 1024, DM, 1024, WOUT_T, 0, 1.0f, scr, r, lane); continue; } r -= J8;
            if (r < J9) { transpose_item(args.in[I_W_XQ], 512, DM, 512, WXQ_T, 0, 0.08838834764831845f * LOG2E, scr, r, lane, args.in[I_LN_X_G]); continue; } r -= J9;
            if (r < J10) { transpose_item(args.in[I_W_XO], 1024, 512, 1024, WXO_T, 0, 1.0f, scr, r, lane); continue; } r -= J10;
            if (r < J11) { const int job = r >> 6, pn = job >> 1, isg = job & 1;
                transpose_item(args.in[I_W_UP] + (isg ? FFN : 0) + 128 * pn, FFN2, DM, 128, WUP_T, 256 * pn + 128 * isg, 1.0f, scr, r & 63, lane, args.in[I_LN_FFN_G]); continue; } r -= J11;
            if (r < J12) { transpose_item(args.in[I_W_DOWN], DM, FFN, DM, WDOWN_T, 0, 1.0f, scr, r, lane); continue; } r -= J12;
            if (r < J13) { transpose_item(args.in[I_CMP_W1_K], 128, 2048, 128, W1K_T, 0, 1.0f, scr, r, lane); continue; } r -= J13;
            if (r < J14) { transpose_item(args.in[I_CMP_W1_V], 128, 2048, 128, W1V_T, 0, 1.0f, scr, r, lane); continue; } r -= J14;
            if (r < J15) { transpose_item(args.in[I_CMP_W2_K], 64, 128, 64, W2K_T, 0, 1.0f, scr, r, lane); continue; } r -= J15;
            transpose_item(args.in[I_CMP_W2_V], 64, 128, 64, W2V_T, 0, 1.0f, scr, r, lane);
        }
        for (int idx = gtid; idx < 256 * 1024; idx += NTH) {
            const int rowi = WROW_TAIL + (idx >> 10), k = idx & 1023;
            const int col = rowi < WROW_ALPHA ? 1280 + (rowi - WROW_TAIL) : (rowi < IN_W ? 2840 + (rowi - WROW_ALPHA) : -1);
            WIN_T[(size_t)rowi * DM + k] = col >= 0 ? (bf16)f2bf(w_in[(size_t)k * IN_W + col]) : (bf16)0;
        }
        if (wave == 0) for (int o = bx; o < 256; o += G) {
            const int kv = o >> 7, j = o & 127; const float* pe = args.in[kv ? I_CMP_POS_V : I_CMP_POS_K]; const float* w1 = args.in[kv ? I_CMP_W1_V : I_CMP_W1_K];
            float pv[32], wv[32];
#pragma unroll
            for (int i = 0; i < 32; ++i) { pv[i] = pe[lane + 64 * i]; wv[i] = w1[(size_t)(lane + 64 * i) * 128 + j]; }
            float s = 0.f;
#pragma unroll
            for (int i = 0; i < 32; ++i) s += pv[i] * wv[i];
            s = wave_sum(s);
            if (lane == 0) C1[o] = s;
        }
        rms_rows_bf16(x, args.in[I_LN_MIX_G], XN0, T, gw, NGW, lane);
        rms_rows_bf16(args.in[I_MEM], args.in[I_LN_MEM_G], MEMN, TM, gw, NGW, lane);
    }
    grid.sync();
    {
        pg8::Gemm g{XN0, WIN_T, T, NWIN, DM}; pg8::StaticOrder S; S.init(T, NWIN, G, bx);
        pg8::EpiWin E{P, PLD, G8, G8LD};
        pg8::gemm_phase<pg8::EpiWin, pg8::StaticOrder, true, true>(lds, g, S, E);
    }
    GRID_SYNC();
    {
        LAS bf16* scr = (LAS bf16*)(lds + wave * 16384);
        for (int it = gw; it < 4096; it += NGW) {
            const int w = it >> 11, r = it & 2047, bh = r >> 5, tt = r & 31, b = bh >> 1, h = bh & 1;
            transpose_tile64(P + (size_t)(b * SEQ + 64 * tt) * PLD + (w ? COL_VW : COL_VS) + h * 64, PLD, (w ? VWT : VST) + (size_t)bh * 64 * SEQ + 64 * tt, SEQ, scr, lane);
        }
        __syncthreads();
        {
            const int ncw = G >= 256 ? 128 : G, gm = G >= 256 ? 128 : G, cm = G >= 256 ? bx - 128 : bx;
            if (bx < ncw) for (int u = bx; u < 128; u += ncw) { const int kv = u >> 6, b = (u >> 1) & 31, h = u & 1;
                compress_unit(kv, b, h, P, kv ? W1V_T : W1K_T, C1 + 128 * kv, kv ? W2V_T : W2K_T, kv ? VCMPT : KCMP, lds, wave, lane); }
            if (cm >= 0) {
                pg8::Gemm g{MEMN, WXKV_T, TM, 1024, DM}; pg8::StaticOrder S; S.init(TM, 1024, gm, cm);
                pg8::EpiBf16<0> E{MEMKV, 1024, nullptr, 0, 0, 1.f};
                pg8::gemm_phase<pg8::EpiBf16<0>, pg8::StaticOrder, true, true>(lds, g, S, E);
            }
        }
    }
    GRID_SYNC();
    {
        LAS bf16* scr = (LAS bf16*)(lds + wave * 16384);
        for (int r = gw; r < 1024; r += NGW) { const int bh = r >> 3, mt = (r >> 1) & 3, dh = r & 1, b = bh >> 2, h = bh & 3;
            transpose_tile64(MEMKV + (size_t)(b * MEM_LEN + 64 * mt) * 1024 + 512 + h * 128 + 64 * dh, 1024, MEMVT + ((size_t)bh * 128 + 64 * dh) * 256 + 64 * mt, 256, scr, lane); }
        __syncthreads();
    }
    {
        unsigned* qctr = (unsigned*)(ws + WS_CTL) + 32;
        volatile LAS int* qslot = (volatile LAS int*)(lds + NS_US + 32);
        if (tid == 0) qslot[0] = (int)__hip_atomic_fetch_add(qctr, 1u, __ATOMIC_RELAXED, __HIP_MEMORY_SCOPE_AGENT);
        __syncthreads();
        int cur = __builtin_amdgcn_readfirstlane(qslot[0]);
#pragma unroll 1
        for (int it = 0; cur < 2048; ++it) {
            if (tid == 0) qslot[(it + 1) & 1] = (int)__hip_atomic_fetch_add(qctr, 1u, __ATOMIC_RELAXED, __HIP_MEMORY_SCOPE_AGENT);
            const int i = 31 - (cur >> 6), bh = cur & 63;
            nsa_unit(bh >> 1, bh & 1, i, P, args.in[I_NSA_GATE_B], KCMP, VCMPT, VST, VWT, ONSA, lds, launder(tid), wave, lane);
            __syncthreads();
            cur = __builtin_amdgcn_readfirstlane(qslot[(it + 1) & 1]);
        }
    }
    for (int item = bx; item < 256; item += G) gla_seq(item, P, args.in[I_GLA_W_ALPHA2], args.in[I_GLA_B_ALPHA], args.in[I_GLA_NORM_G], OGLA, lds, launder(tid), wave, lane);
    GRID_SYNC();
    {
        pg8::StaticOrder S; S.init(T, DM, G, bx);
        { pg8::Gemm g{ONSA, WBN_T, T, DM, 512}; pg8::EpiGate E{G8, G8LD, MIX, DM, 0}; pg8::gemm_phase<pg8::EpiGate, pg8::StaticOrder, true, true>(lds, g, S, E); }
        { pg8::Gemm g{OGLA, WBG_T, T, DM, 512}; pg8::EpiGate E{G8 + 1024, G8LD, MIX, DM, 1}; pg8::gemm_phase<pg8::EpiGate, pg8::StaticOrder, true, true>(lds, g, S, E); }
    }
    GRID_SYNC();
    {
        pg8::Gemm g{MIX, WOUT_T, T, DM, DM}; pg8::StaticOrder S; S.init(T, DM, G, bx);
        typedef pg8::EpiResT<false, false, true> EpiT; EpiT E{x, nullptr, DM, XN, ROWSS1};
        pg8::gemm_phase<EpiT, pg8::StaticOrder, true, true>(lds, g, S, E);
    }
    GRID_SYNC();
    {
        pg8::Gemm g{XN, WXQ_T, T, 512, DM}; pg8::StaticOrder S; S.init(T, 512, G, bx);
        pg8::EpiBf16RS E{XQ, 512, ROWSS1, 1.0f / DM, RMS_EPS};
        pg8::gemm_phase<pg8::EpiBf16RS, pg8::StaticOrder, true, true>(lds, g, S, E);
    }
    GRID_SYNC();
    for (int item = bx; item < 256; item += G) xattn_item(item, XQ, MEMKV, MEMVT, XO, lds, launder(tid), wave, lane);
    GRID_SYNC();
    {
        pg8::Gemm g{XO, WXO_T, T, DM, 512}; pg8::StaticOrder S; S.init(T, DM, G, bx);
        typedef pg8::EpiResT<true, false, true> EpiT; EpiT E{nullptr, nullptr, DM, XN, ROWSS2};
        pg8::gemm_phase<EpiT, pg8::StaticOrder, true, true>(lds, g, S, E);
    }
    GRID_SYNC();
    {
        pg8::Gemm g{XN, WUP_T, T, FFN2, DM}; pg8::StaticOrder S; S.init(T, FFN2, G, bx);
        pg8::EpiFfnAct E{ACT, FFN, args.in[I_CONV_W], args.in[I_CONV_B], FFN, SIDE_U, SIDE_G, (LAS float*)(lds + 131072), ROWSS2, 1.0f / DM, RMS_EPS};
        pg8::gemm_phase<pg8::EpiFfnAct, pg8::StaticOrder, true, true>(lds, g, S, E);
    }
    GRID_SYNC();
    ffn_fixup(SIDE_U, SIDE_G, args.in[I_CONV_W], args.in[I_CONV_B], ACT, gtid, NTH);
    GRID_SYNC();
    if (G == 256) {
        pg8::Gemm g{ACT, WDOWN_T, T, DM, FFN}; pg8::StaticOrder S; S.init(T, DM, G, bx);
        pg8::EpiFinalNorm E{XN, out, DM, args.in[I_LN_FINAL_G], (float*)(ws + WS_FSLOT), (unsigned*)ROWSS3, (unsigned*)(ws + WS_CTL) + 16, (LAS float*)(lds + 131072), 1.0f / DM, RMS_EPS};
        pg8::gemm_phase<pg8::EpiFinalNorm, pg8::StaticOrder, true, true>(lds, g, S, E);
    } else {
        {
            pg8::Gemm g{ACT, WDOWN_T, T, DM, FFN}; pg8::StaticOrder S; S.init(T, DM, G, bx);
            typedef pg8::EpiResT<true, false, true> EpiT; EpiT E{nullptr, nullptr, DM, XN, ROWSS3};
            pg8::gemm_phase<EpiT, pg8::StaticOrder, true, true>(lds, g, S, E);
        }
        GRID_SYNC();
        final_norm_rows(XN, ROWSS3, args.in[I_LN_FINAL_G], out, gtid, NTH);
    }
}

extern "C" void kernel_launch(void* const* d_in, const int* in_sizes, int n_in, void* d_out, int out_size, void* d_ws, size_t ws_size, hipStream_t stream) {
    static int grid = 0;
    if (grid == 0) {
        if (n_in != 28 || out_size != T * DM || ws_size < WS_END) { fprintf(stderr, "kernel_launch: unexpected shapes n_in %d out %d ws %zu\n", n_in, out_size, ws_size); grid = -1; return; }
        int dev = 0, cus = 0, per_cu = 0;
        if (hipGetDevice(&dev) != hipSuccess || hipDeviceGetAttribute(&cus, hipDeviceAttributeMultiprocessorCount, dev) != hipSuccess) { grid = -1; return; }
        if (hipFuncSetAttribute((const void*)fwd_kernel, hipFuncAttributeMaxDynamicSharedMemorySize, LDS_BYTES) != hipSuccess) { fprintf(stderr, "kernel_launch: hipFuncSetAttribute failed\n"); grid = -1; return; }
        if (hipOccupancyMaxActiveBlocksPerMultiprocessor(&per_cu, (const void*)fwd_kernel, NTHREADS, LDS_BYTES) != hipSuccess || per_cu < 1) { fprintf(stderr, "kernel_launch: occupancy query says %d\n", per_cu); (void)hipGetLastError(); per_cu = 1; }
        grid = cus;
    }
    if (grid < 0) return;
    (void)hipMemsetAsync((char*)d_ws + WS_CTL, 0, 1 * MiB, stream);
    Args a{};
    for (int i = 0; i < 28; ++i) a.in[i] = (const float*)d_in[i];
    a.out = (float*)d_out; a.ws = (unsigned char*)d_ws;
    void* kargs[] = {&a};
    hipError_t e = hipLaunchCooperativeKernel((const void*)fwd_kernel, dim3(grid), dim3(NTHREADS), kargs, LDS_BYTES, stream);
    if (e != hipSuccess) fprintf(stderr, "kernel_launch: cooperative launch failed: %s (grid %d)\n", hipGetErrorString(e), grid);
}
```

```cpp
#include <hip/hip_runtime.h>
#include <hip/hip_cooperative_groups.h>
#include <cstdio>
#include <cstdint>
namespace cg = cooperative_groups;
namespace pg8 {
#define PG8_LAS __attribute__((address_space(3)))
typedef unsigned short bf16_t;
typedef short bf16x8 __attribute__((ext_vector_type(8)));
typedef float f32x4 __attribute__((ext_vector_type(4)));
typedef unsigned u32x4 __attribute__((ext_vector_type(4)));
constexpr int BM = 256, BK = 64, HALF = 128, HTB = HALF * BK * 2  , STAGE_BYTES = 8 * HTB, NXCD = 8, WGM = 8;

__host__ __device__ __forceinline__ int lds_byte(int r, int c) { const int st = (r >> 4) * 2 + (c >> 5), rr = r & 15, cc = c & 31, ob = rr * 64 + cc * 2; return st * 1024 + (ob ^ (((ob >> 9) & 1) << 5)); }
__host__ __device__ __forceinline__ void stage_rc(int b, int& R, int& C) { const int st = b / 1024, sb = b % 1024, swz = sb ^ (((sb >> 9) & 1) << 5); R = (st >> 1) * 16 + swz / 64; C = (st & 1) * 32 + (swz % 64) / 2; }
__host__ __device__ __forceinline__ int perm32(int rho) { const int n = rho >> 4, i = rho & 15; return 8 * (i >> 2) + 4 * n + (i & 3); }

struct Unit { int pm, pn; };
struct Gemm { const bf16_t* A; const bf16_t* Bt; int M, N, K; };

struct StaticOrder {
    int nM, nN, nwg, G, c;
    __host__ __device__ void init(int M, int N, int G_, int c_) { nM = M / BM; nN = N / BM; nwg = nM * nN; G = G_; c = c_; }
    __host__ __device__ bool next(int i, Unit& u) const {
        const long L = (long)i * G + c; if (L >= nwg) return false;
        int wgid = (int)L; { const int q = nwg / NXCD, r = nwg % NXCD, xcd = wgid % NXCD, off = wgid / NXCD; wgid = (xcd < r ? xcd * (q + 1) : r * (q + 1) + (xcd - r) * q) + off; }
        const int nig = WGM * nN, gid = wgid / nig, fm = gid * WGM, gsz = (nM - fm) < WGM ? (nM - fm) : WGM;
        u.pm = fm + ((wgid % nig) % gsz); u.pn = (wgid % nig) / gsz; return true;
    }
    __device__ __forceinline__ void a_ready(const Unit&) const {}
    __device__ __forceinline__ void done(const Unit&) const {}
};

__device__ __forceinline__ unsigned cvt_pk_bf16(float lo, float hi) { unsigned r; asm volatile("v_cvt_pk_bf16_f32 %0, %1, %2" : "=v"(r) : "v"(lo), "v"(hi)); return r; }
typedef float f32x2 __attribute__((ext_vector_type(2)));
__device__ __forceinline__ f32x2 gelu_pk(f32x2 v) {
    const f32x2 av = __builtin_elementwise_abs(v), d = av * 0.2316418882f + 1.0f;
    f32x2 t; t.x = __builtin_amdgcn_rcpf(d.x); t.y = __builtin_amdgcn_rcpf(d.y);
    f32x2 q = t * 0.5307027145f + (-0.7265760135f); q = q * t + 0.7107068705f; q = q * t + (-0.142248368f); q = q * t + 0.127414796f; q = q * t;
    const f32x2 s = (v * v) * (-0.72134752044f);
    f32x2 e; e.x = __builtin_amdgcn_exp2f(s.x); e.y = __builtin_amdgcn_exp2f(s.y);
    const f32x2 m = v * (q * e), r = v - m;
    f32x2 o; o.x = v.x < 0.f ? m.x : r.x; o.y = v.y < 0.f ? m.y : r.y; return o;
}

template <int ACT  > struct EpiBf16 {
    static constexpr bool PERM = true, AFTER_DRAIN = false; static_assert(ACT == 0 || ACT == 1, "EpiBf16: ACT is 0 (none) or 1 (gelu_pk)");
    bf16_t* O; int ldc; const float* bias; int split_cols; size_t split_stride; float scale0;
    __device__ __forceinline__ void operator()(const f32x4 (&acc)[2][2][4][2], const Unit& u, int wr, int wc, int fr, int fq) const {
        const int row0 = u.pm * BM + wr * 64 + fr; int colt = u.pn * BM; bf16_t* base = O;
        float sc = 1.f; if (split_cols) { const int t = colt / split_cols; base += (size_t)t * split_stride; colt -= t * split_cols; if (t == 0) sc = scale0; }
        const int col0 = colt + wc * 32 + 8 * fq, bcol0 = u.pn * BM + wc * 32 + 8 * fq;
        f32x4 bv[2][2];
#pragma unroll
        for (int bj = 0; bj < 2; ++bj)
#pragma unroll
            for (int n = 0; n < 2; ++n) bv[bj][n] = bias ? *(const f32x4*)(bias + bcol0 + bj * HALF + 4 * n) : (f32x4){0.f, 0.f, 0.f, 0.f};
#pragma unroll
        for (int ai = 0; ai < 2; ++ai)
#pragma unroll
            for (int m = 0; m < 4; ++m) { bf16_t* rowp = base + (size_t)(row0 + ai * HALF + m * 16) * ldc + col0;
#pragma unroll
                for (int bj = 0; bj < 2; ++bj) { f32x4 v0 = acc[ai][bj][m][0] + bv[bj][0], v1 = acc[ai][bj][m][1] + bv[bj][1];
                    if (ACT == 1) { f32x2 a = gelu_pk((f32x2){v0[0], v0[1]}), b = gelu_pk((f32x2){v0[2], v0[3]}), c = gelu_pk((f32x2){v1[0], v1[1]}), d = gelu_pk((f32x2){v1[2], v1[3]});
                        v0 = (f32x4){a.x, a.y, b.x, b.y}; v1 = (f32x4){c.x, c.y, d.x, d.y}; }
                    v0 = v0 * sc; v1 = v1 * sc; u32x4 w; w.x = cvt_pk_bf16(v0[0], v0[1]); w.y = cvt_pk_bf16(v0[2], v0[3]); w.z = cvt_pk_bf16(v1[0], v1[1]); w.w = cvt_pk_bf16(v1[2], v1[3]);
                    *(u32x4*)(rowp + bj * HALF) = w; } }
    }
};

template <bool BASE_BF16, bool WRITE_F32, bool WRITE_XR>
struct EpiResT {
    static constexpr bool PERM = true, AFTER_DRAIN = false;
    const float* base; float* C; int ldc; bf16_t* XR; float* rowss;
    __device__ __forceinline__ void operator()(const f32x4 (&acc)[2][2][4][2], const Unit& u, int wr, int wc, int fr, int fq) const {
        const int row0 = u.pm * BM + wr * 64 + fr, col0 = u.pn * BM + wc * 32 + 8 * fq;
#pragma unroll
        for (int ai = 0; ai < 2; ++ai) {
            f32x4 b[4][2][2];
#pragma unroll
            for (int m = 0; m < 4; ++m) { const size_t off = (size_t)(row0 + ai * HALF + m * 16) * ldc + col0;
#pragma unroll
                for (int bj = 0; bj < 2; ++bj) {
                    if (BASE_BF16) { const u32x4 w = *(const u32x4*)(XR + off + bj * HALF);
                        b[m][bj][0] = (f32x4){__builtin_bit_cast(float, w.x << 16), __builtin_bit_cast(float, w.x & 0xffff0000u), __builtin_bit_cast(float, w.y << 16), __builtin_bit_cast(float, w.y & 0xffff0000u)};
                        b[m][bj][1] = (f32x4){__builtin_bit_cast(float, w.z << 16), __builtin_bit_cast(float, w.z & 0xffff0000u), __builtin_bit_cast(float, w.w << 16), __builtin_bit_cast(float, w.w & 0xffff0000u)}; }
                    else { b[m][bj][0] = *(const f32x4*)(base + off + bj * HALF); b[m][bj][1] = *(const f32x4*)(base + off + bj * HALF + 4); } } }
            asm volatile("" ::: "memory");
#pragma unroll
            for (int m = 0; m < 4; ++m) { const int row = row0 + ai * HALF + m * 16; const size_t off = (size_t)row * ldc + col0;
                float ss = 0.f;
#pragma unroll
                for (int bj = 0; bj < 2; ++bj) { const size_t o = off + bj * HALF;
                    const f32x4 v0 = b[m][bj][0] + acc[ai][bj][m][0], v1 = b[m][bj][1] + acc[ai][bj][m][1];
                    if (WRITE_F32) { *(f32x4*)(C + o) = v0; *(f32x4*)(C + o + 4) = v1; }
                    if (WRITE_XR) {
                        ss += (v0[0] * v0[0] + v0[1] * v0[1]) + (v0[2] * v0[2] + v0[3] * v0[3]) + (v1[0] * v1[0] + v1[1] * v1[1]) + (v1[2] * v1[2] + v1[3] * v1[3]);
                        u32x4 w; w.x = cvt_pk_bf16(v0[0], v0[1]); w.y = cvt_pk_bf16(v0[2], v0[3]); w.z = cvt_pk_bf16(v1[0], v1[1]); w.w = cvt_pk_bf16(v1[2], v1[3]);
                        *(u32x4*)(XR + o) = w; } }
                if (WRITE_XR) { ss += __shfl_xor(ss, 16); ss += __shfl_xor(ss, 32); if (fq == 0) atomicAdd(rowss + row, ss); } }
        }
    }
};
struct EpiBf16RS {
    static constexpr bool PERM = true, AFTER_DRAIN = false;
    bf16_t* O; int ldc; const float* rowss; float inv_nk, eps;
    __device__ __forceinline__ void operator()(const f32x4 (&acc)[2][2][4][2], const Unit& u, int wr, int wc, int fr, int fq) const {
        const int row0 = u.pm * BM + wr * 64 + fr, col0 = u.pn * BM + wc * 32 + 8 * fq;
        float rsv[2][4];
#pragma unroll
        for (int ai = 0; ai < 2; ++ai)
#pragma unroll
            for (int m = 0; m < 4; ++m) rsv[ai][m] = rowss[row0 + ai * HALF + m * 16];
        asm volatile("" ::: "memory");
#pragma unroll
        for (int ai = 0; ai < 2; ++ai)
#pragma unroll
            for (int m = 0; m < 4; ++m) { const int row = row0 + ai * HALF + m * 16; const float rs = 1.0f / sqrtf(rsv[ai][m] * inv_nk + eps);
                bf16_t* rowp = O + (size_t)row * ldc + col0;
#pragma unroll
                for (int bj = 0; bj < 2; ++bj) { const f32x4 v0 = acc[ai][bj][m][0] * rs, v1 = acc[ai][bj][m][1] * rs;
                    u32x4 w; w.x = cvt_pk_bf16(v0[0], v0[1]); w.y = cvt_pk_bf16(v0[2], v0[3]); w.z = cvt_pk_bf16(v1[0], v1[1]); w.w = cvt_pk_bf16(v1[2], v1[3]);
                    *(u32x4*)(rowp + bj * HALF) = w; } }
    }
};
__device__ __forceinline__ float bf2f(unsigned short b) { return __builtin_bit_cast(float, (unsigned)b << 16); }
__device__ __forceinline__ float sigmoidf_fast(float x) { return __builtin_amdgcn_rcpf(1.0f + __builtin_amdgcn_exp2f(-1.4426950408889634f * x)); }
struct EpiWin {
    static constexpr bool PERM = true, AFTER_DRAIN = false;
    bf16_t* P; int ldp; unsigned char* G8; int ldg;
    __device__ __forceinline__ void operator()(const f32x4 (&acc)[2][2][4][2], const Unit& u, int wr, int wc, int fr, int fq) const {
        const int row0 = u.pm * BM + wr * 64 + fr, cl = wc * 32 + 8 * fq;
        if (u.pn >= 11 && u.pn <= 18) {
            unsigned char* base = G8 + (u.pn - 11) * BM + cl;
#pragma unroll
            for (int ai = 0; ai < 2; ++ai)
#pragma unroll
                for (int m = 0; m < 4; ++m) { unsigned char* rowp = base + (size_t)(row0 + ai * HALF + m * 16) * ldg;
#pragma unroll
                    for (int bj = 0; bj < 2; ++bj) { unsigned q[8];
#pragma unroll
                        for (int e = 0; e < 4; ++e) { q[e] = (unsigned)(sigmoidf_fast(acc[ai][bj][m][0][e]) * 255.0f + 0.5f); q[4 + e] = (unsigned)(sigmoidf_fast(acc[ai][bj][m][1][e]) * 255.0f + 0.5f); }
                        typedef unsigned u32x2 __attribute__((ext_vector_type(2)));
                        u32x2 w; w.x = q[0] | (q[1] << 8) | (q[2] << 16) | (q[3] << 24); w.y = q[4] | (q[5] << 8) | (q[6] << 16) | (q[7] << 24);
                        *(u32x2*)(rowp + bj * HALF) = w; } }
        } else {
            bf16_t* base = P + (u.pn == 19 ? 2816 : u.pn * BM) + cl;
#pragma unroll
            for (int ai = 0; ai < 2; ++ai)
#pragma unroll
                for (int m = 0; m < 4; ++m) { bf16_t* rowp = base + (size_t)(row0 + ai * HALF + m * 16) * ldp;
#pragma unroll
                    for (int bj = 0; bj < 2; ++bj) { const f32x4 v0 = acc[ai][bj][m][0], v1 = acc[ai][bj][m][1];
                        u32x4 w; w.x = cvt_pk_bf16(v0[0], v0[1]); w.y = cvt_pk_bf16(v0[2], v0[3]); w.z = cvt_pk_bf16(v1[0], v1[1]); w.w = cvt_pk_bf16(v1[2], v1[3]);
                        *(u32x4*)(rowp + bj * HALF) = w; } }
        }
    }
};
struct EpiGate {
    static constexpr bool PERM = true, AFTER_DRAIN = false;
    const unsigned char* gate; int ldg; bf16_t* O; int ldc; int accum;
    __device__ __forceinline__ void operator()(const f32x4 (&acc)[2][2][4][2], const Unit& u, int wr, int wc, int fr, int fq) const {
        typedef unsigned u32x2 __attribute__((ext_vector_type(2)));
        const int row0 = u.pm * BM + wr * 64 + fr, col0 = u.pn * BM + wc * 32 + 8 * fq;
#pragma unroll
        for (int ai = 0; ai < 2; ++ai) {
            u32x2 gv[4][2]; u32x4 pv[4][2];
#pragma unroll
            for (int m = 0; m < 4; ++m) { const size_t row = (size_t)(row0 + ai * HALF + m * 16);
#pragma unroll
                for (int bj = 0; bj < 2; ++bj) { gv[m][bj] = *(const u32x2*)(gate + row * ldg + col0 + bj * HALF);
                    pv[m][bj] = accum ? *(const u32x4*)(O + row * ldc + col0 + bj * HALF) : (u32x4){0u, 0u, 0u, 0u}; } }
            asm volatile("" ::: "memory");
#pragma unroll
            for (int m = 0; m < 4; ++m) { const size_t row = (size_t)(row0 + ai * HALF + m * 16);
#pragma unroll
                for (int bj = 0; bj < 2; ++bj) {
                    float g[8], v[8];
#pragma unroll
                    for (int e = 0; e < 4; ++e) { g[e] = (float)((gv[m][bj].x >> (8 * e)) & 0xffu) * (1.0f / 255.0f); g[4 + e] = (float)((gv[m][bj].y >> (8 * e)) & 0xffu) * (1.0f / 255.0f); }
#pragma unroll
                    for (int e = 0; e < 4; ++e) { v[e] = acc[ai][bj][m][0][e] * g[e]; v[4 + e] = acc[ai][bj][m][1][e] * g[4 + e]; }
#pragma unroll
                    for (int e = 0; e < 4; ++e) { v[2 * e] += bf2f((unsigned short)(pv[m][bj][e] & 0xffffu)); v[2 * e + 1] += bf2f((unsigned short)(pv[m][bj][e] >> 16)); }
                    u32x4 w; w.x = cvt_pk_bf16(v[0], v[1]); w.y = cvt_pk_bf16(v[2], v[3]); w.z = cvt_pk_bf16(v[4], v[5]); w.w = cvt_pk_bf16(v[6], v[7]);
                    *(u32x4*)(O + row * ldc + col0 + bj * HALF) = w; } }
        }
    }
};
struct EpiFinalNorm {
    static constexpr bool PERM = true, AFTER_DRAIN = false;
    const bf16_t* XR; float* out; int ldc; const float* gain; float* slots; unsigned* cnt; unsigned* tmo; PG8_LAS float* tab; float inv_nk, eps;
    __device__ __forceinline__ void operator()(f32x4 (&acc)[2][2][4][2], const Unit& u, int wr, int wc, int fr, int fq) const {
        const int row0 = u.pm * BM + wr * 64 + fr, col0 = u.pn * BM + wc * 32 + 8 * fq;
        const int lane = fr | (fq << 4), wid = 4 * wr + wc, tid = wid * 64 + lane;
        PG8_LAS float* Pst = tab; PG8_LAS float* Srow = tab + 1024; PG8_LAS unsigned* flag = (PG8_LAS unsigned*)(tab + 1280);
#pragma unroll
        for (int ai = 0; ai < 2; ++ai) {
            u32x4 b[4][2];
#pragma unroll
            for (int m = 0; m < 4; ++m)
#pragma unroll
                for (int bj = 0; bj < 2; ++bj) b[m][bj] = *(const u32x4*)(XR + (size_t)(row0 + ai * HALF + m * 16) * ldc + col0 + bj * HALF);
#pragma unroll
            for (int m = 0; m < 4; ++m) { float ss = 0.f;
#pragma unroll
                for (int bj = 0; bj < 2; ++bj) { const u32x4 w = b[m][bj];
                    const f32x4 x0 = {__builtin_bit_cast(float, w.x << 16), __builtin_bit_cast(float, w.x & 0xffff0000u), __builtin_bit_cast(float, w.y << 16), __builtin_bit_cast(float, w.y & 0xffff0000u)};
                    const f32x4 x1 = {__builtin_bit_cast(float, w.z << 16), __builtin_bit_cast(float, w.z & 0xffff0000u), __builtin_bit_cast(float, w.w << 16), __builtin_bit_cast(float, w.w & 0xffff0000u)};
                    const f32x4 v0 = acc[ai][bj][m][0] + x0, v1 = acc[ai][bj][m][1] + x1; acc[ai][bj][m][0] = v0; acc[ai][bj][m][1] = v1;
                    ss += (v0[0] * v0[0] + v0[1] * v0[1]) + (v0[2] * v0[2] + v0[3] * v0[3]) + (v1[0] * v1[0] + v1[1] * v1[1]) + (v1[2] * v1[2] + v1[3] * v1[3]); }
                ss += __shfl_xor(ss, 16); ss += __shfl_xor(ss, 32);
                if (fq == 0) Pst[(ai * HALF + wr * 64 + m * 16 + fr) * 4 + wc] = ss; }
        }
        asm volatile("s_waitcnt lgkmcnt(0)" ::: "memory"); __builtin_amdgcn_s_barrier(); asm volatile("" ::: "memory");
        if (tid < 256) { const float t = (Pst[tid * 4 + 0] + Pst[tid * 4 + 1]) + (Pst[tid * 4 + 2] + Pst[tid * 4 + 3]);
            __hip_atomic_store(slots + ((size_t)(u.pm * BM + tid) * 4 + u.pn), t, __ATOMIC_RELAXED, __HIP_MEMORY_SCOPE_AGENT); }
        asm volatile("s_waitcnt vmcnt(0)" ::: "memory");
        if (lane == 0) __hip_atomic_fetch_add(cnt + 64 * u.pm, 1u, __ATOMIC_RELAXED, __HIP_MEMORY_SCOPE_AGENT);
        if (wid == 0) {
            bool dead = false; unsigned spins = 0;
            while ((unsigned)__builtin_amdgcn_readfirstlane(__hip_atomic_load(cnt + 64 * u.pm, __ATOMIC_RELAXED, __HIP_MEMORY_SCOPE_AGENT)) < 32u) {
                __builtin_amdgcn_s_sleep(2);
                if (++spins > (1u << 22)) { if (lane == 0) __hip_atomic_store(tmo, 1u, __ATOMIC_RELAXED, __HIP_MEMORY_SCOPE_AGENT); dead = true; break; } }
            __builtin_amdgcn_fence(__ATOMIC_ACQUIRE, "agent");
            if (lane == 0) flag[0] = dead ? 1u : 0u;
        }
        asm volatile("s_waitcnt vmcnt(0) lgkmcnt(0)" ::: "memory"); __builtin_amdgcn_s_barrier(); asm volatile("" ::: "memory");
        if (tid < 256) { const float* sl = slots + (size_t)(u.pm * BM + tid) * 4; float t = 0.f;
#pragma unroll
            for (int k = 0; k < 4; ++k) t += __hip_atomic_load(sl + k, __ATOMIC_RELAXED, __HIP_MEMORY_SCOPE_AGENT);
            Srow[tid] = __builtin_amdgcn_rsqf(t * inv_nk + eps); }
        asm volatile("s_waitcnt vmcnt(0) lgkmcnt(0)" ::: "memory"); __builtin_amdgcn_s_barrier(); asm volatile("" ::: "memory");
        f32x4 gv[2][2];
#pragma unroll
        for (int bj = 0; bj < 2; ++bj) { gv[bj][0] = *(const f32x4*)(gain + col0 + bj * HALF); gv[bj][1] = *(const f32x4*)(gain + col0 + bj * HALF + 4); }
#pragma unroll
        for (int ai = 0; ai < 2; ++ai)
#pragma unroll
            for (int m = 0; m < 4; ++m) { const int rl = ai * HALF + wr * 64 + m * 16 + fr; const float rs = Srow[rl]; float* op = out + (size_t)(u.pm * BM + rl) * ldc + col0;
#pragma unroll
                for (int bj = 0; bj < 2; ++bj) { *(f32x4*)(op + bj * HALF) = acc[ai][bj][m][0] * rs * gv[bj][0]; *(f32x4*)(op + bj * HALF + 4) = acc[ai][bj][m][1] * rs * gv[bj][1]; } }
    }
};
__device__ __forceinline__ float gelu_tanh_f(float x) {
    const float z = x * (1.5957691216057308f + 0.07135481627260025f * x * x);
    return x * __builtin_amdgcn_rcpf(1.0f + __builtin_amdgcn_exp2f(-1.4426950408889634f * z));
}
template <int CTRL> __device__ __forceinline__ float dpp_rot(float v) { return __builtin_bit_cast(float, __builtin_amdgcn_update_dpp(0, __builtin_bit_cast(int, v), CTRL, 0xF, 0xF, false)); }
struct EpiFfnAct {
    static constexpr bool PERM = true, AFTER_DRAIN = false;
    bf16_t* ACT; int ldc; const float* conv_w; const float* conv_b; int nch; float* SIDE_U; float* SIDE_G; PG8_LAS float* halo; const float* rowss; float inv_nk, eps;
    __device__ __forceinline__ void operator()(f32x4 (&acc)[2][2][4][2], const Unit& u, int wr, int wc, int fr, int fq) const {
        const int chl = wc * 32 + 8 * fq, chg = u.pn * 128 + chl, rbase = u.pm * BM + wr * 64;
        float rs[2][4], rh[2][2];
#pragma unroll
        for (int ai = 0; ai < 2; ++ai) {
#pragma unroll
            for (int m = 0; m < 4; ++m) rs[ai][m] = rowss[rbase + ai * HALF + m * 16 + fr];
            const int r0 = rbase + ai * HALF; rh[ai][0] = rowss[r0 >= 2 ? r0 - 2 : 0]; rh[ai][1] = rowss[r0 >= 1 ? r0 - 1 : 0];
        }
        f32x4 w0[2], w1[2], w2[2], cb[2];
#pragma unroll
        for (int n = 0; n < 2; ++n) { w0[n] = *(const f32x4*)(conv_w + chg + 4 * n); w1[n] = *(const f32x4*)(conv_w + nch + chg + 4 * n); w2[n] = *(const f32x4*)(conv_w + 2 * nch + chg + 4 * n); cb[n] = *(const f32x4*)(conv_b + chg + 4 * n); }
        if (fr >= 14) {
#pragma unroll
            for (int ai = 0; ai < 2; ++ai)
#pragma unroll
                for (int n = 0; n < 2; ++n) *(PG8_LAS f32x4*)(halo + ((2 * ai + wr) * 2 + (fr - 14)) * 128 + chl + 4 * n) = acc[ai][0][3][n];
        }
        asm volatile("s_waitcnt lgkmcnt(0)" ::: "memory"); __builtin_amdgcn_s_barrier(); asm volatile("" ::: "memory");
#pragma unroll
        for (int ai = 0; ai < 2; ++ai) {
            const int k = 2 * ai + wr;
            f32x4 p1[2], p2[2];
            if (k >= 1) {
                const float s2 = 1.0f / sqrtf(rh[ai][0] * inv_nk + eps), s1 = 1.0f / sqrtf(rh[ai][1] * inv_nk + eps);
#pragma unroll
                for (int n = 0; n < 2; ++n) { const f32x4 h2 = *(const PG8_LAS f32x4*)(halo + ((k - 1) * 2 + 0) * 128 + chl + 4 * n) * s2, h1 = *(const PG8_LAS f32x4*)(halo + ((k - 1) * 2 + 1) * 128 + chl + 4 * n) * s1;
                    p1[n] = h1;
#pragma unroll
                    for (int e = 0; e < 4; ++e) p2[n][e] = fr == 0 ? h2[e] : h1[e]; }
            } else {
#pragma unroll
                for (int n = 0; n < 2; ++n) { p1[n] = (f32x4){0.f, 0.f, 0.f, 0.f}; p2[n] = (f32x4){0.f, 0.f, 0.f, 0.f}; }
            }
#pragma unroll
            for (int m = 0; m < 4; ++m) {
                const float rsm = 1.0f / sqrtf(rs[ai][m] * inv_nk + eps);
                const size_t row = (size_t)(rbase + ai * HALF + m * 16 + fr);
                float o[8];
#pragma unroll
                for (int n = 0; n < 2; ++n) {
                    acc[ai][0][m][n] = acc[ai][0][m][n] * rsm; acc[ai][1][m][n] = acc[ai][1][m][n] * rsm;
#pragma unroll
                    for (int e = 0; e < 4; ++e) {
                        const float cur = acc[ai][0][m][n][e];
                        const float r1 = dpp_rot<0x121>(cur), r2 = dpp_rot<0x122>(cur);
                        const float um1 = fr >= 1 ? r1 : p1[n][e], um2 = fr >= 2 ? r2 : p2[n][e];
                        p1[n][e] = r1; p2[n][e] = r2;
                        const float cv = w0[n][e] * um2 + w1[n][e] * um1 + w2[n][e] * cur + cb[n][e];
                        o[4 * n + e] = gelu_tanh_f(cv) * acc[ai][1][m][n][e];
                    }
                }
                u32x4 w; w.x = cvt_pk_bf16(o[0], o[1]); w.y = cvt_pk_bf16(o[2], o[3]); w.z = cvt_pk_bf16(o[4], o[5]); w.w = cvt_pk_bf16(o[6], o[7]);
                *(u32x4*)(ACT + row * ldc + chg) = w;
            }
        }
        if (wr == 0 && fr < 2) {
#pragma unroll
            for (int n = 0; n < 2; ++n) { *(f32x4*)(SIDE_U + ((size_t)u.pm * 4 + fr) * nch + chg + 4 * n) = acc[0][0][0][n]; *(f32x4*)(SIDE_G + ((size_t)u.pm * 2 + fr) * nch + chg + 4 * n) = acc[0][1][0][n]; }
        }
        if (wr == 1 && fr >= 14) {
#pragma unroll
            for (int n = 0; n < 2; ++n) *(f32x4*)(SIDE_U + ((size_t)u.pm * 4 + 2 + (fr - 14)) * nch + chg + 4 * n) = acc[1][0][3][n];
        }
    }
};

template <class Epi, class Sched, bool ALIGN_EPI = false, bool SP2 = false>
__device__ __forceinline__ void gemm_phase(PG8_LAS unsigned char* lds, const Gemm g, const Sched& S, const Epi& E) {
    int tid_ = threadIdx.x; asm volatile("" : "+v"(tid_)); const int tid = tid_, wid = __builtin_amdgcn_readfirstlane(tid >> 6), lane = tid & 63, wr = wid >> 2, wc = wid & 3, fr = lane & 15, fq = lane >> 4;
    const int K = g.K, nt = K / BK;
    unsigned voffA[2], voffB[2];
#pragma unroll
    for (int i = 0; i < 2; ++i) { int R, C; stage_rc(tid * 16 + i * 8192, R, C); const int Rb = Epi::PERM ? ((R & ~31) + perm32(R & 31)) : R;
        voffA[i] = (unsigned)(R * K + C) * 2u; voffB[i] = (unsigned)(Rb * K + C) * 2u; }
    const size_t kstep = (size_t)(BK * 2);
    const size_t hstep = (size_t)HALF * K * 2;
    const size_t tstep = 2 * hstep;
    const unsigned ldsw = (unsigned)wid * 1024u;
    const int aoff = lds_byte(wr * 64 + fr, fq * 8), boff = lds_byte(wc * 32 + fr, fq * 8);
#define PG8_SA(b, h) (((b) * 2 + (h)) * HTB)
#define PG8_SB(b, h) ((4 + (b) * 2 + (h)) * HTB)
#define PG8_STAGE(bufoff, gbase, voff) do { _Pragma("unroll") for (int _i = 0; _i < 2; ++_i) \
        __builtin_amdgcn_global_load_lds((const unsigned*)((const char*)(gbase) + (voff)[_i]), (PG8_LAS unsigned*)(lds + (bufoff) + ldsw + _i * 8192), 16, 0, 0); } while (0)
#define PG8_LDA(dst, b, h) do { _Pragma("unroll") for (int m = 0; m < 4; ++m) _Pragma("unroll") for (int k = 0; k < 2; ++k) dst[m][k] = *(const PG8_LAS bf16x8*)(lds + PG8_SA(b, h) + aoff + m * 2048 + k * 1024); } while (0)
#define PG8_LDB(dst, b, h) do { _Pragma("unroll") for (int n = 0; n < 2; ++n) _Pragma("unroll") for (int k = 0; k < 2; ++k) dst[n][k] = *(const PG8_LAS bf16x8*)(lds + PG8_SB(b, h) + boff + n * 2048 + k * 1024); } while (0)
#define PG8_MMA(ai, bj, At, Bt) do { __builtin_amdgcn_s_setprio(1); _Pragma("unroll") for (int m = 0; m < 4; ++m) _Pragma("unroll") for (int n = 0; n < 2; ++n) _Pragma("unroll") for (int k = 0; k < 2; ++k) \
        acc[ai][bj][m][n] = __builtin_amdgcn_mfma_f32_16x16x32_bf16(Bt[n][k], At[m][k], acc[ai][bj][m][n], 0, 0, 0); __builtin_amdgcn_s_setprio(0); } while (0)
#define PG8_WAIT_V(n) asm volatile("s_waitcnt vmcnt(" #n ")" ::: "memory")
#define PG8_WAIT_L(n) asm volatile("s_waitcnt lgkmcnt(" #n ")" ::: "memory")
#define PG8_BAR __builtin_amdgcn_s_barrier()
#define PG8_SCHED __builtin_amdgcn_sched_barrier(0)
    Unit cur, nxt; int ui = 0;
    if (!S.next(0, cur)) return;
    f32x4 acc[2][2][4][2];
#pragma unroll
    for (int a = 0; a < 2; ++a)
#pragma unroll
        for (int b = 0; b < 2; ++b)
#pragma unroll
            for (int m = 0; m < 4; ++m)
#pragma unroll
                for (int n = 0; n < 2; ++n) acc[a][b][m][n] = (f32x4){0.f, 0.f, 0.f, 0.f};
    bf16x8 At[4][2], B0[2][2], B1[2][2];
    const char* cA = (const char*)g.A + (size_t)cur.pm * tstep; const char* cB = (const char*)g.Bt + (size_t)cur.pn * tstep;
    S.a_ready(cur);
    if constexpr (SP2) {
        PG8_STAGE(PG8_SB(0, 0), cB, voffB); PG8_STAGE(PG8_SB(0, 1), cB + hstep, voffB); PG8_STAGE(PG8_SA(0, 0), cA, voffA); PG8_STAGE(PG8_SA(0, 1), cA + hstep, voffA);
        if (wr == 1) PG8_BAR;
        PG8_WAIT_V(2); PG8_BAR;
        PG8_STAGE(PG8_SB(1, 0), cB + kstep, voffB); PG8_STAGE(PG8_SA(1, 0), cA + kstep, voffA); PG8_STAGE(PG8_SB(1, 1), cB + hstep + kstep, voffB);
        PG8_WAIT_V(6); PG8_BAR;
    } else {
        PG8_STAGE(PG8_SB(0, 0), cB, voffB); PG8_STAGE(PG8_SA(0, 0), cA, voffA); PG8_STAGE(PG8_SB(0, 1), cB + hstep, voffB); PG8_STAGE(PG8_SA(0, 1), cA + hstep, voffA);
        if (wr == 1) PG8_BAR;
        PG8_WAIT_V(4); PG8_BAR;
        PG8_STAGE(PG8_SB(1, 0), cB + kstep, voffB); PG8_STAGE(PG8_SA(1, 0), cA + kstep, voffA); PG8_STAGE(PG8_SB(1, 1), cB + hstep + kstep, voffB);
        PG8_WAIT_V(6); PG8_BAR;
    }
    for (;;) {
        const bool has_next = S.next(ui + 1, nxt);
        const char* nA = has_next ? (const char*)g.A + (size_t)nxt.pm * tstep : cA; const char* nB = has_next ? (const char*)g.Bt + (size_t)nxt.pn * tstep : cB;
        for (int t = 0; t < nt; t += 2) {
            const bool last = (t == nt - 2);
            const char* a1 = cA + (size_t)(t + 1) * kstep;
            const char* a2 = last ? nA : cA + (size_t)(t + 2) * kstep; const char* b2 = last ? nB : cB + (size_t)(t + 2) * kstep;
            const char* a3 = a2 + kstep; const char* b3 = b2 + kstep;
            if (last && has_next) S.a_ready(nxt);
            if constexpr (SP2) {
            PG8_LDB(B0, 0, 0); PG8_LDB(B1, 0, 1); PG8_SCHED; PG8_LDA(At, 0, 0); PG8_STAGE(PG8_SA(1, 1), a1 + hstep, voffA);
            PG8_WAIT_V(8); PG8_WAIT_L(0); PG8_BAR; PG8_MMA(0, 0, At, B0); PG8_MMA(0, 1, At, B1); PG8_BAR; PG8_SCHED;
            PG8_LDA(At, 0, 1); PG8_STAGE(PG8_SB(0, 0), b2, voffB); PG8_STAGE(PG8_SB(0, 1), b2 + hstep, voffB); PG8_STAGE(PG8_SA(0, 0), a2, voffA);
            PG8_WAIT_V(8); PG8_WAIT_L(0); PG8_BAR; PG8_MMA(1, 0, At, B0); PG8_MMA(1, 1, At, B1); PG8_BAR; PG8_SCHED;
            PG8_LDB(B0, 1, 0); PG8_LDB(B1, 1, 1); PG8_SCHED; PG8_LDA(At, 1, 0); PG8_STAGE(PG8_SA(0, 1), a2 + hstep, voffA);
            PG8_WAIT_V(8); PG8_WAIT_L(0); PG8_BAR; PG8_MMA(0, 0, At, B0); PG8_MMA(0, 1, At, B1); PG8_BAR; PG8_SCHED;
            PG8_LDA(At, 1, 1); PG8_STAGE(PG8_SB(1, 0), b3, voffB); PG8_STAGE(PG8_SB(1, 1), b3 + hstep, voffB); PG8_STAGE(PG8_SA(1, 0), a3, voffA);
            PG8_WAIT_V(8); PG8_WAIT_L(0); PG8_BAR; PG8_MMA(1, 0, At, B0); PG8_MMA(1, 1, At, B1); PG8_BAR; PG8_SCHED;
            } else {
            PG8_LDB(B0, 0, 0); PG8_SCHED; PG8_LDA(At, 0, 0); PG8_STAGE(PG8_SA(1, 1), a1 + hstep, voffA);
            PG8_WAIT_L(8); PG8_BAR; PG8_WAIT_L(0); PG8_MMA(0, 0, At, B0); PG8_BAR; PG8_SCHED;
            PG8_LDB(B1, 0, 1); PG8_STAGE(PG8_SB(0, 0), b2, voffB);
            PG8_BAR; PG8_WAIT_L(0); PG8_MMA(0, 1, At, B1); PG8_BAR;
            PG8_LDA(At, 0, 1); PG8_STAGE(PG8_SA(0, 0), a2, voffA);
            PG8_BAR; PG8_WAIT_L(0); PG8_MMA(1, 0, At, B0); PG8_BAR; PG8_SCHED;
            PG8_STAGE(PG8_SB(0, 1), b2 + hstep, voffB);
            PG8_WAIT_V(6); PG8_BAR; PG8_MMA(1, 1, At, B1); PG8_BAR;
            PG8_LDB(B0, 1, 0); PG8_SCHED; PG8_LDA(At, 1, 0); PG8_STAGE(PG8_SA(0, 1), a2 + hstep, voffA);
            PG8_WAIT_L(8); PG8_BAR; PG8_WAIT_L(0); PG8_MMA(0, 0, At, B0); PG8_BAR; PG8_SCHED;
            PG8_LDB(B1, 1, 1); PG8_STAGE(PG8_SB(1, 0), b3, voffB);
            PG8_BAR; PG8_WAIT_L(0); PG8_MMA(0, 1, At, B1); PG8_BAR;
            PG8_LDA(At, 1, 1); PG8_STAGE(PG8_SA(1, 0), a3, voffA);
            PG8_BAR; PG8_WAIT_L(0); PG8_MMA(1, 0, At, B0); PG8_BAR; PG8_SCHED;
            PG8_STAGE(PG8_SB(1, 1), b3 + hstep, voffB);
            PG8_WAIT_V(6); PG8_BAR; PG8_MMA(1, 1, At, B1); PG8_BAR;
            }
        }
        if constexpr (ALIGN_EPI) { if (wr == 0) PG8_BAR; }
        if constexpr (!Epi::AFTER_DRAIN) { E(acc, cur, wr, wc, fr, fq); S.done(cur); }
        if (!has_next) break;
#pragma unroll
        for (int a = 0; a < 2; ++a)
#pragma unroll
            for (int b = 0; b < 2; ++b)
#pragma unroll
                for (int m = 0; m < 4; ++m)
#pragma unroll
                    for (int n = 0; n < 2; ++n) acc[a][b][m][n] = (f32x4){0.f, 0.f, 0.f, 0.f};
        cur = nxt; cA = nA; cB = nB; ++ui;
        if constexpr (ALIGN_EPI) { if (wr == 1) PG8_BAR; }
    }
    PG8_WAIT_V(0);
    if constexpr (!ALIGN_EPI) { if (wr == 0) PG8_BAR; }
    PG8_BAR;
    if constexpr (Epi::AFTER_DRAIN) { E.fused(acc, cur, wr, wc, fr, fq, lds, wid, lane); S.done(cur); }
#undef PG8_SA
#undef PG8_SB
#undef PG8_STAGE
#undef PG8_LDA
#undef PG8_LDB
#undef PG8_MMA
#undef PG8_WAIT_V
#undef PG8_WAIT_L
#undef PG8_BAR
#undef PG8_SCHED
}
}

constexpr int NWAVES = 8, NTHREADS = 512;
constexpr int BATCH = 32, SEQ = 2048, DM = 1024, T = BATCH * SEQ;
constexpr int MEM_LEN = 256, TM = BATCH * MEM_LEN;
constexpr int FFN = 2816, FFN2 = 2 * FFN;
constexpr float RMS_EPS = 1e-6f;
constexpr float LOG2E = 1.4426950408889634f;
constexpr int PLD = 3072, NWIN = 5120, IN_W = 4904;
constexpr int COL_QA = 0, COL_KC = 512, COL_VC = 640, COL_KS = 768, COL_VS = 896, COL_KW = 1024, COL_VW = 1152, COL_QB = 1280, COL_KB = 1536, COL_VB = 1792, COL_RB = 2304,
              COL_GATE = 2816, COL_ALPHA = 2840;
constexpr int WROW_GN = 2816, WROW_TAIL = 4864, WROW_ALPHA = 4888;
constexpr int G8LD = 2048;

constexpr size_t MiB = 1u << 20, KiB = 1u << 10;
constexpr size_t WS_CTL = 0;
constexpr size_t WS_ROWSS = 64 * KiB;
constexpr size_t WS_WIN = 1 * MiB;
constexpr size_t WS_WUP = 11 * MiB;
constexpr size_t WS_WDOWN = 22 * MiB;
constexpr size_t WS_WXKV = 28 * MiB;
constexpr size_t WS_WOUT = 30 * MiB;
constexpr size_t WS_WBN = 32 * MiB;
constexpr size_t WS_WBG = 33 * MiB;
constexpr size_t WS_WXQ = 34 * MiB;
constexpr size_t WS_WXO = 35 * MiB;
constexpr size_t WS_W1K = 36 * MiB;
constexpr size_t WS_W1V = 36 * MiB + 512 * KiB;
constexpr size_t WS_W2K = 37 * MiB;
constexpr size_t WS_W2V = 37 * MiB + 16 * KiB;
constexpr size_t WS_C1 = 37 * MiB + 32 * KiB;
constexpr size_t WS_A = 48 * MiB;
constexpr size_t WS_XN0 = WS_A;
constexpr size_t WS_XN = 176 * MiB + 512 * MiB;
constexpr size_t WS_VST = WS_A;
constexpr size_t WS_VWT = WS_A + 16 * MiB;
constexpr size_t WS_KCMP = WS_A + 32 * MiB;
constexpr size_t WS_VCMPT = WS_A + 33 * MiB;
constexpr size_t WS_MIX = WS_A;
constexpr size_t WS_B = 176 * MiB;
constexpr size_t WS_P = WS_B;
constexpr size_t WS_G8 = WS_B + 384 * MiB;
constexpr size_t WS_XQ = WS_B;
constexpr size_t WS_XO = WS_B + 64 * MiB;
constexpr size_t WS_ACT = WS_B;
constexpr size_t WS_C = 816 * MiB;
constexpr size_t WS_MEMN = WS_C;
constexpr size_t WS_MEMKV = WS_C + 16 * MiB;
constexpr size_t WS_ONSA = WS_C + 32 * MiB;
constexpr size_t WS_OGLA = WS_C + 96 * MiB;
constexpr size_t WS_MEMVT2 = WS_C + 160 * MiB;
constexpr size_t WS_FSLOT = WS_C + 32 * MiB;
constexpr size_t WS_SIDEU = WS_C;
constexpr size_t WS_SIDEG = WS_C + 16 * MiB;
constexpr size_t WS_END = 1024 * MiB;

constexpr int LDS_BYTES = 147456;

#define LAS __attribute__((address_space(3)))
typedef unsigned short bf16;
typedef unsigned v4u __attribute__((ext_vector_type(4)));
typedef unsigned v2u __attribute__((ext_vector_type(2)));
typedef float f32x4 __attribute__((ext_vector_type(4)));
typedef float f32x16 __attribute__((ext_vector_type(16)));
typedef short bf16x8 __attribute__((ext_vector_type(8)));
#define LDS_WAIT() asm volatile("s_waitcnt lgkmcnt(0)" ::: "memory")
#define MFMA32(a, b, c) __builtin_amdgcn_mfma_f32_32x32x16_bf16((a), (b), (c), 0, 0, 0)

typedef float f32x2_t __attribute__((ext_vector_type(2))); typedef __bf16 bf16x2_t __attribute__((ext_vector_type(2)));
__device__ __forceinline__ unsigned pk2(float lo, float hi) { const f32x2_t v = {lo, hi}; return __builtin_bit_cast(unsigned, __builtin_convertvector(v, bf16x2_t)); }
__device__ __forceinline__ unsigned f2bf(float f) { return pk2(f, 0.f) & 0xffffu; }
__device__ __forceinline__ float bflo(unsigned w) { return __builtin_bit_cast(float, w << 16); }
__device__ __forceinline__ float bfhi(unsigned w) { return __builtin_bit_cast(float, w & 0xffff0000u); }
__device__ __forceinline__ float bf2f(bf16 b) { return __builtin_bit_cast(float, (unsigned)b << 16); }
__device__ __forceinline__ float ex2(float x) { return __builtin_amdgcn_exp2f(x); }
__device__ __forceinline__ float sigmoid_f(float x) { return __builtin_amdgcn_rcpf(1.0f + ex2(-LOG2E * x)); }
__device__ __forceinline__ int crow(int r, int g) { return (r & 3) + 8 * (r >> 2) + 4 * g; }
__device__ __forceinline__ int launder(int v) { asm volatile("" : "+v"(v)); return v; }
__device__ __forceinline__ float wave_sum(float v) {
#pragma unroll
    for (int o = 1; o < 64; o <<= 1) v += __shfl_xor(v, o);
    return v;
}
__device__ __forceinline__ f32x16 zero16() { f32x16 z;
#pragma unroll
    for (int r = 0; r < 16; ++r) z[r] = 0.f;
    return z; }
__device__ __forceinline__ float gelu_tanh(float x) {
    const float z = x * (1.5957691216057308f + 0.07135481627260025f * x * x);
    return x * __builtin_amdgcn_rcpf(1.0f + ex2(-LOG2E * z));
}
__device__ __forceinline__ bf16x8 pack8(const float* p) { v4u w; w.x = pk2(p[0], p[1]); w.y = pk2(p[2], p[3]); w.z = pk2(p[4], p[5]); w.w = pk2(p[6], p[7]); return __builtin_bit_cast(bf16x8, w); }

__device__ __forceinline__ void transpose_item(const float* W, int ldw, int K, int ncols, bf16* WT, int row_off, float scale, LAS float* scr, int item, int lane, const float* kscale = nullptr) {
    const int nblk = ncols / 32, kb = item / nblk, nb = item % nblk, k0 = 64 * kb, n0 = 32 * nb;
    float wv[32];
#pragma unroll
    for (int i = 0; i < 32; ++i) wv[i] = __builtin_nontemporal_load(W + (size_t)(k0 + 2 * i + (lane >> 5)) * ldw + n0 + (lane & 31));
#pragma unroll
    for (int i = 0; i < 32; ++i) { const int kk = 2 * i + (lane >> 5); scr[kk * 33 + (lane & 31)] = wv[i] * (kscale ? scale * kscale[k0 + kk] : scale); }
    LDS_WAIT(); asm volatile("" ::: "memory");
    const int c = lane & 7;
#pragma unroll
    for (int j = 0; j < 4; ++j) { const int n = (lane >> 3) + 8 * j; const LAS float* s = scr + (8 * c) * 33 + n;
        v4u o; o.x = pk2(s[0 * 33], s[1 * 33]); o.y = pk2(s[2 * 33], s[3 * 33]); o.z = pk2(s[4 * 33], s[5 * 33]); o.w = pk2(s[6 * 33], s[7 * 33]);
        *(v4u*)(WT + (size_t)(row_off + n0 + n) * K + k0 + 8 * c) = o; }
    LDS_WAIT(); asm volatile("" ::: "memory");
}

__device__ __forceinline__ void rms_rows_bf16(const float* X, const float* g, bf16* O, int nrows, int gw, int NGW, int lane) {
    f32x4 gv[4];
#pragma unroll
    for (int j = 0; j < 4; ++j) gv[j] = *((const f32x4*)g + lane + 64 * j);
    for (int m0 = 4 * gw; m0 < nrows; m0 += 4 * NGW) {
        f32x4 v[4][4];
#pragma unroll
        for (int r = 0; r < 4; ++r) { const f32x4* xr = (const f32x4*)(X + (size_t)(m0 + r) * DM) + lane;
#pragma unroll
            for (int j = 0; j < 4; ++j) v[r][j] = __builtin_nontemporal_load(xr + 64 * j); }
#pragma unroll
        for (int r = 0; r < 4; ++r) asm volatile("" :: "v"(v[r][0]), "v"(v[r][1]), "v"(v[r][2]), "v"(v[r][3]));
#pragma unroll
        for (int r = 0; r < 4; ++r) {
            float s = 0.f;
#pragma unroll
            for (int j = 0; j < 4; ++j) s += (v[r][j].x * v[r][j].x + v[r][j].y * v[r][j].y) + (v[r][j].z * v[r][j].z + v[r][j].w * v[r][j].w);
            const float rstd = __builtin_amdgcn_rsqf(wave_sum(s) * (1.0f / DM) + RMS_EPS);
            v2u* o8 = (v2u*)(O + (size_t)(m0 + r) * DM) + lane;
#pragma unroll
            for (int j = 0; j < 4; ++j) { v2u w; w.x = pk2(v[r][j].x * rstd * gv[j].x, v[r][j].y * rstd * gv[j].y); w.y = pk2(v[r][j].z * rstd * gv[j].z, v[r][j].w * rstd * gv[j].w); o8[64 * j] = w; }
        }
    }
}
__device__ __forceinline__ void final_norm_rows(const bf16* XR, const float* rowss, const float* g, float* out, int gtid, int nthreads) {
    for (int id = gtid; id < T * (DM / 8); id += nthreads) {
        const int row = id >> 7, c0 = (id & 127) * 8;
        const v4u w = *(const v4u*)(XR + (size_t)row * DM + c0);
        const float rs = 1.0f / sqrtf(rowss[row] * (1.0f / DM) + RMS_EPS);
        const f32x4 g0 = *(const f32x4*)(g + c0), g1 = *(const f32x4*)(g + c0 + 4);
        f32x4 o0, o1;
        o0.x = bflo(w.x) * rs * g0.x; o0.y = bfhi(w.x) * rs * g0.y; o0.z = bflo(w.y) * rs * g0.z; o0.w = bfhi(w.y) * rs * g0.w;
        o1.x = bflo(w.z) * rs * g1.x; o1.y = bfhi(w.z) * rs * g1.y; o1.z = bflo(w.w) * rs * g1.z; o1.w = bfhi(w.w) * rs * g1.w;
        *(f32x4*)(out + (size_t)row * DM + c0) = o0; *(f32x4*)(out + (size_t)row * DM + c0 + 4) = o1;
    }
}

__device__ __forceinline__ void ffn_fixup(const float* SIDE_U, const float* SIDE_G, const float* conv_w, const float* conv_b, bf16* ACT, int gtid, int nthreads) {
    constexpr int NCG = FFN / 8, NTASK = (T / 256) * 2 * NCG;
    for (int id = gtid; id < NTASK; id += nthreads) {
        const int cgp = id % NCG, r = (id / NCG) & 1, pm = id / (2 * NCG), c0 = cgp * 8;
        if ((pm & 7) == 0) continue;
        const float* A = SIDE_U + ((size_t)(pm - 1) * 4 + 2) * FFN + c0; const float* B = SIDE_U + ((size_t)(pm - 1) * 4 + 3) * FFN + c0;
        const float* C = SIDE_U + ((size_t)pm * 4 + 0) * FFN + c0; const float* D = SIDE_U + ((size_t)pm * 4 + 1) * FFN + c0;
        const float* pm2 = r ? B : A; const float* pm1 = r ? C : B; const float* pu = r ? D : C; const float* pg = SIDE_G + ((size_t)pm * 2 + r) * FFN + c0;
        float o[8];
#pragma unroll
        for (int h = 0; h < 2; ++h) {
            const f32x4 w0 = *(const f32x4*)(conv_w + c0 + 4 * h), w1 = *(const f32x4*)(conv_w + FFN + c0 + 4 * h), w2 = *(const f32x4*)(conv_w + 2 * FFN + c0 + 4 * h), cb = *(const f32x4*)(conv_b + c0 + 4 * h);
            const f32x4 um2 = *(const f32x4*)(pm2 + 4 * h), um1 = *(const f32x4*)(pm1 + 4 * h), u = *(const f32x4*)(pu + 4 * h), g = *(const f32x4*)(pg + 4 * h);
#pragma unroll
            for (int e = 0; e < 4; ++e) o[4 * h + e] = gelu_tanh(w0[e] * um2[e] + w1[e] * um1[e] + w2[e] * u[e] + cb[e]) * g[e];
        }
        v4u w; w.x = pk2(o[0], o[1]); w.y = pk2(o[2], o[3]); w.z = pk2(o[4], o[5]); w.w = pk2(o[6], o[7]);
        *(v4u*)(ACT + ((size_t)pm * 256 + r) * FFN + c0) = w;
    }
}

__device__ __forceinline__ void transpose_tile64(const bf16* src, int sld, bf16* dst, int dld, LAS bf16* scr, int lane) {
#pragma unroll
    for (int k = 0; k < 8; ++k) { const int id = lane + 64 * k, row = id >> 3, ch = id & 7; const v4u v = *(const v4u*)(src + (size_t)row * sld + ch * 8);
        LAS unsigned* w = (LAS unsigned*)(scr + row * 66 + ch * 8); w[0] = v.x; w[1] = v.y; w[2] = v.z; w[3] = v.w; }
    LDS_WAIT(); asm volatile("" ::: "memory");
#pragma unroll
    for (int k = 0; k < 8; ++k) { const int col = (lane >> 3) + 8 * k, tc = lane & 7; unsigned short s[8];
#pragma unroll
        for (int j = 0; j < 8; ++j) s[j] = scr[(8 * tc + j) * 66 + col];
        v4u o; o.x = (unsigned)s[0] | ((unsigned)s[1] << 16); o.y = (unsigned)s[2] | ((unsigned)s[3] << 16); o.z = (unsigned)s[4] | ((unsigned)s[5] << 16); o.w = (unsigned)s[6] | ((unsigned)s[7] << 16);
        *(v4u*)(dst + (size_t)col * dld + 8 * tc) = o; }
    LDS_WAIT(); asm volatile("" ::: "memory");
}

__device__ __forceinline__ void compress_unit(int kv, int b, int h, const bf16* P, const bf16* W1T, const float* c1, const bf16* W2T, bf16* outp, LAS unsigned char* lds, int wave, int lane) {
    const int r32 = lane & 31, g = lane >> 5;
    {
        const int nt = wave >> 1, jh = wave & 1, tid = wave * 64 + lane;
        constexpr int CB = 36864, CA0 = 0, CW0 = 18432;
        const bf16* abase = P + (size_t)(b * SEQ) * PLD + (kv ? COL_VC : COL_KC) + h * 64;
        v4u ra[2], rw[2];
#define CMP_LOAD(pos_) do { _Pragma("unroll") for (int k_ = 0; k_ < 2; ++k_) { const int id_ = tid + 512 * k_, row_ = id_ >> 3, ch_ = id_ & 7; int tok_ = 16 * row_ + (pos_); tok_ = tok_ > SEQ - 1 ? SEQ - 1 : tok_; \
            ra[k_] = *(const v4u*)(abase + (size_t)tok_ * PLD + 8 * ch_); rw[k_] = *(const v4u*)(W1T + (size_t)row_ * 2048 + (pos_) * 64 + 8 * ch_); } } while (0)
#define CMP_STORE(buf_) do { _Pragma("unroll") for (int k_ = 0; k_ < 2; ++k_) { const int id_ = tid + 512 * k_, row_ = id_ >> 3, ch_ = id_ & 7; \
            *(LAS v4u*)(lds + (buf_) * CB + CA0 + row_ * 144 + ch_ * 16) = ra[k_]; *(LAS v4u*)(lds + (buf_) * CB + CW0 + row_ * 144 + ch_ * 16) = rw[k_]; } } while (0)
        CMP_LOAD(0); CMP_STORE(0);
        __syncthreads();
        CMP_LOAD(1);
        f32x16 acc0 = zero16(), acc1 = zero16();
#pragma unroll 1
        for (int pos = 0; pos < 32; ++pos) {
            const LAS unsigned char* Ab = lds + (pos & 1) * CB + CA0; const LAS unsigned char* Wb = lds + (pos & 1) * CB + CW0;
            bf16x8 af[4], w0f[4], w1f[4];
#pragma unroll
            for (int sd = 0; sd < 4; ++sd) { af[sd] = *(const LAS bf16x8*)(Ab + (32 * nt + r32) * 144 + (16 * sd + 8 * g) * 2);
                w0f[sd] = *(const LAS bf16x8*)(Wb + (64 * jh + r32) * 144 + (16 * sd + 8 * g) * 2); w1f[sd] = *(const LAS bf16x8*)(Wb + (64 * jh + 32 + r32) * 144 + (16 * sd + 8 * g) * 2); }
#pragma unroll
            for (int sd = 0; sd < 4; ++sd) { acc0 = MFMA32(af[sd], w0f[sd], acc0); acc1 = MFMA32(af[sd], w1f[sd], acc1); }
            if (pos + 1 < 32) CMP_STORE((pos + 1) & 1);
            __syncthreads();
            if (pos + 2 < 32) CMP_LOAD(pos + 2);
        }
#undef CMP_LOAD
#undef CMP_STORE
        LAS bf16* G = (LAS bf16*)(lds + 73728);
#pragma unroll
        for (int jt = 0; jt < 2; ++jt) { const int j = 64 * jh + 32 * jt + r32; const float cj = c1[j];
#pragma unroll
            for (int r = 0; r < 16; ++r) { const int nn = 32 * nt + crow(r, g); const float v = gelu_tanh((jt ? acc1[r] : acc0[r]) + cj); G[nn * 136 + j] = (bf16)f2bf(v); } }
    }
    __syncthreads();
    {
        const int nt2 = wave >> 1, et = wave & 1;
        f32x16 acc = zero16();
#pragma unroll
        for (int s = 0; s < 8; ++s) {
            const bf16x8 gf = *(const LAS bf16x8*)(lds + 73728 + ((32 * nt2 + r32) * 136 + 16 * s + 8 * g) * 2);
            const bf16x8 wf = *(const bf16x8*)(W2T + (32 * et + r32) * 128 + 16 * s + 8 * g);
            acc = kv ? MFMA32(wf, gf, acc) : MFMA32(gf, wf, acc);
        }
        if (!kv) {
            bf16* o = outp + (size_t)(b * 2 + h) * 128 * 64;
#pragma unroll
            for (int r = 0; r < 16; ++r) { const int n = 32 * nt2 + crow(r, g), e = 32 * et + r32; o[n * 64 + e] = (n == 127) ? (bf16)0 : (bf16)f2bf(acc[r]); }
        } else {
            bf16* o = outp + (size_t)(b * 2 + h) * 64 * 128;
#pragma unroll
            for (int r = 0; r < 16; ++r) { const int e = 32 * et + crow(r, g), n = 32 * nt2 + r32; o[e * 128 + n] = (n == 127) ? (bf16)0 : (bf16)f2bf(acc[r]); }
        }
    }
    __syncthreads();
}

template <int CTRL> __device__ __forceinline__ float dppf(float v) { return __builtin_bit_cast(float, __builtin_amdgcn_update_dpp(0, __builtin_bit_cast(int, v), CTRL, 0xF, 0xF, false)); }
constexpr int GS_TOT = 0, GS_QD = 2048, GS_KD = 11264, GS_KST = 20480, GS_VT = 29696, GS_ATT = 48128, GS_SSQ = 52736, GS_DEC = 53248,
              GS_RA = 53504, GS_RQ = 55552, GS_RK = 63744, GS_RV = 71936, GS_XL = 88320, GS_OB = 106496;
struct GlaPre { v4u a, q, k, v0, v1, r; };
__device__ __forceinline__ void gla_prefetch(GlaPre& pf, const bf16* base, int h, int ith, int tid) {
    if (tid < 256) pf.a = *(const v4u*)(base + (size_t)(32 * ((tid >> 6) >> 1) + (tid & 31)) * PLD + COL_ALPHA + 8 * ((tid >> 5) & 1));
    const bf16* rp = base + (size_t)(tid >> 3) * PLD + h * 64 + 8 * (tid & 7);
    pf.k = *(const v4u*)(rp + COL_KB); pf.q = *(const v4u*)(rp + COL_QB);
    const bf16* vp0 = base + (size_t)(tid >> 4) * PLD + h * 128 + 8 * (tid & 15);
    pf.v0 = *(const v4u*)(vp0 + COL_VB); pf.v1 = *(const v4u*)(vp0 + (size_t)32 * PLD + COL_VB);
    pf.r = *(const v4u*)(vp0 + (size_t)(32 * ith) * PLD + COL_RB);
}
__device__ __forceinline__ void gla_seq(int item, const bf16* P, const float* w_alpha2, const float* b_alpha, const float* norm_g, bf16* OGLA, LAS unsigned char* lds, int tid, int wave, int lane) {
    const int b = item >> 3, h = (item >> 1) & 3, ith = item & 1;
    const int d = tid & 63, r32 = lane & 31, g = lane >> 5, et = wave & 3;
    LAS float* TOT = (LAS float*)(lds + GS_TOT); LAS float* SSQ = (LAS float*)(lds + GS_SSQ); LAS float* DECL = (LAS float*)(lds + GS_DEC);
    LAS bf16* QD = (LAS bf16*)(lds + GS_QD); LAS bf16* KD = (LAS bf16*)(lds + GS_KD); LAS bf16* KST = (LAS bf16*)(lds + GS_KST); LAS bf16* VT = (LAS bf16*)(lds + GS_VT); LAS bf16* ATT = (LAS bf16*)(lds + GS_ATT);
    LAS bf16* RQ = (LAS bf16*)(lds + GS_RQ); LAS bf16* RK = (LAS bf16*)(lds + GS_RK); LAS bf16* RV = (LAS bf16*)(lds + GS_RV);
    const bf16* Pb = P + (size_t)b * SEQ * PLD;
    bf16x8 w2f; float biasc;
    {   float wv[8]; const int col = 32 * (wave & 1) + r32;
#pragma unroll
        for (int j = 0; j < 8; ++j) wv[j] = w_alpha2[(8 * g + j) * 256 + h * 64 + col];
        w2f = pack8(wv); biasc = b_alpha[h * 64 + col]; }
    LAS float* XL = (LAS float*)(lds + GS_XL);
    float g8[8];
#pragma unroll
    for (int k = 0; k < 8; ++k) g8[k] = norm_g[8 * (tid & 15) + k];
    LAS float* OB = (LAS float*)(lds + GS_OB);
    f32x16 S0 = zero16(), S1 = zero16();
    GlaPre pf; gla_prefetch(pf, Pb, h, ith, tid);
#pragma unroll 1
    for (int n = 0; n < 32; ++n) {
        const size_t row0 = (size_t)b * SEQ + 64 * n;
        if (wave < 4) {
            const f32x16 xg = MFMA32(__builtin_bit_cast(bf16x8, pf.a), w2f, zero16());
#pragma unroll
            for (int r = 0; r < 16; ++r) XL[(32 * (wave >> 1) + crow(r, g)) * 64 + 32 * (wave & 1) + r32] = xg[r] + biasc;
        }
        *(LAS v4u*)(lds + GS_RK + tid * 16) = pf.k; *(LAS v4u*)(lds + GS_RQ + tid * 16) = pf.q;
        *(LAS v4u*)(lds + GS_RV + tid * 16) = pf.v0; *(LAS v4u*)(lds + GS_RV + 8192 + tid * 16) = pf.v1;
        const v4u rcur = pf.r;
        if (n + 1 < 32) gla_prefetch(pf, Pb + (size_t)(64 * (n + 1)) * PLD, h, ith, tid);
        __syncthreads();
        float c[8];
        {
            float run = 0.f;
#pragma unroll
            for (int k = 0; k < 8; ++k) {
                const float x = XL[(8 * wave + k) * 64 + d];
                const float ls = fminf(x, 0.f) - __logf(1.0f + __expf(-fabsf(x)));
                run += ls * (1.0f / 16.0f); c[k] = run;
            }
            TOT[wave * 64 + d] = run;
        }
        __syncthreads();
        {
            float off = 0.f, blast = 0.f;
#pragma unroll
            for (int w = 0; w < 8; ++w) { const float tv = TOT[w * 64 + d]; blast += tv; off += (w < wave) ? tv : 0.f; }
            float ks[8];
#pragma unroll
            for (int k = 0; k < 8; ++k) {
                const int tok = 8 * wave + k; const float bk = off + c[k];
                const float kvv = bf2f(RK[tok * 64 + d]), qv = bf2f(RQ[tok * 64 + d]);
                QD[tok * 72 + d] = (bf16)f2bf(qv * __expf(bk)); KD[tok * 72 + d] = (bf16)f2bf(kvv * __expf(-bk));
                ks[k] = kvv * __expf(blast - bk);
            }
            *(LAS bf16x8*)(KST + d * 72 + 8 * wave) = pack8(ks);
            if (wave == 0) DECL[d] = __expf(blast);
            const int e = tid & 127, tg = tid >> 7;
            unsigned short vv[16];
#pragma unroll
            for (int k = 0; k < 16; ++k) vv[k] = RV[(16 * tg + k) * 128 + e];
            v4u w0, w1;
#pragma unroll
            for (int k = 0; k < 4; ++k) { w0[k] = (unsigned)vv[2 * k] | ((unsigned)vv[2 * k + 1] << 16); w1[k] = (unsigned)vv[8 + 2 * k] | ((unsigned)vv[8 + 2 * k + 1] << 16); }
            *(LAS v4u*)(VT + e * 72 + 16 * tg) = w0; *(LAS v4u*)(VT + e * 72 + 16 * tg + 8) = w1;
        }
        __syncthreads();
        f32x16 o = zero16();
        if (wave < 4) {
#pragma unroll
            for (int dt = 0; dt < 2; ++dt)
#pragma unroll
                for (int sp = 0; sp < 2; ++sp) {
                    float pp[8];
#pragma unroll
                    for (int j = 0; j < 8; ++j) pp[j] = dt ? S1[8 * sp + j] : S0[8 * sp + j];
                    const bf16x8 sb = pack8(pp);
                    const LAS bf16* qrow = QD + (32 * ith + r32) * 72 + 32 * dt + 16 * sp + 4 * g;
                    const v2u lo = *(const LAS v2u*)qrow, hi = *(const LAS v2u*)(qrow + 8);
                    v4u w; w.x = lo.x; w.y = lo.y; w.z = hi.x; w.w = hi.y;
                    o = MFMA32(__builtin_bit_cast(bf16x8, w), sb, o);
                }
#pragma unroll
            for (int r = 0; r < 16; ++r) { S0[r] *= DECL[crow(r, g)]; S1[r] *= DECL[32 + crow(r, g)]; }
#pragma unroll
            for (int s = 0; s < 4; ++s) {
                const bf16x8 vb = *(const LAS bf16x8*)(VT + (32 * et + r32) * 72 + 16 * s + 8 * g);
                const bf16x8 k0 = *(const LAS bf16x8*)(KST + r32 * 72 + 16 * s + 8 * g), k1 = *(const LAS bf16x8*)(KST + (32 + r32) * 72 + 16 * s + 8 * g);
                S0 = MFMA32(k0, vb, S0); S1 = MFMA32(k1, vb, S1);
            }
        } else if (wave < 6) {
            const int jt = wave - 4;
            f32x16 acc = zero16();
            if (jt <= ith) {
#pragma unroll
                for (int s = 0; s < 4; ++s) {
                    const bf16x8 a = *(const LAS bf16x8*)(QD + (32 * ith + r32) * 72 + 16 * s + 8 * g);
                    const bf16x8 bb = *(const LAS bf16x8*)(KD + (32 * jt + r32) * 72 + 16 * s + 8 * g);
                    acc = MFMA32(a, bb, acc);
                }
            }
#pragma unroll
            for (int r = 0; r < 16; ++r) { const int il = crow(r, g), j = 32 * jt + r32; ATT[il * 72 + j] = (bf16)f2bf(j <= 32 * ith + il ? acc[r] : 0.f); }
        }
        __syncthreads();
        if (wave < 4) {
#pragma unroll
            for (int s = 0; s < 4; ++s) {
                const bf16x8 a = *(const LAS bf16x8*)(ATT + r32 * 72 + 16 * s + 8 * g);
                const bf16x8 bb = *(const LAS bf16x8*)(VT + (32 * et + r32) * 72 + 16 * s + 8 * g);
                o = MFMA32(a, bb, o);
            }
#pragma unroll
            for (int r = 0; r < 16; ++r) OB[crow(r, g) * 128 + 32 * et + r32] = o[r];
        }
        __syncthreads();
        {
            const int rowl = tid >> 4, c8 = 8 * (tid & 15);
            const f32x4 x0 = *(const LAS f32x4*)(OB + rowl * 128 + c8), x1 = *(const LAS f32x4*)(OB + rowl * 128 + c8 + 4);
            float ss = (x0[0] * x0[0] + x0[1] * x0[1]) + (x0[2] * x0[2] + x0[3] * x0[3]) + (x1[0] * x1[0] + x1[1] * x1[1]) + (x1[2] * x1[2] + x1[3] * x1[3]);
            ss += dppf<0xB1>(ss); ss += dppf<0x4E>(ss); ss += dppf<0x124>(ss); ss += dppf<0x128>(ss);
            const float rstd = __builtin_amdgcn_rsqf(ss * (1.0f / 128.0f) + RMS_EPS);
            float ov[8];
#pragma unroll
            for (int k = 0; k < 4; ++k) { const float r0 = bflo(rcur[k]), r1 = bfhi(rcur[k]);
                ov[2 * k] = (k < 2 ? x0[2 * k] : x1[2 * k - 4]) * rstd * g8[2 * k] * (r0 * sigmoid_f(r0));
                ov[2 * k + 1] = (k < 2 ? x0[2 * k + 1] : x1[2 * k - 3]) * rstd * g8[2 * k + 1] * (r1 * sigmoid_f(r1)); }
            *(bf16x8*)(OGLA + (row0 + 32 * ith + rowl) * 512 + h * 128 + c8) = pack8(ov);
        }
    }
    __syncthreads();
}


template <int D> struct FlashState { f32x16 o[D / 32]; float m, l; };
template <int D> __device__ __forceinline__ void flash_reset(FlashState<D>& st) {
#pragma unroll
    for (int t = 0; t < D / 32; ++t) st.o[t] = zero16();
    st.m = -1e30f; st.l = 0.f;
}
__device__ __forceinline__ void half_swap(float x, float& a, float& b) { unsigned ua = __builtin_bit_cast(unsigned, x), ub = ua;
    asm("s_nop 1\n\tv_permlane32_swap_b32 %0, %1\n\ts_nop 1" : "+v"(ua), "+v"(ub)); a = __builtin_bit_cast(float, ua); b = __builtin_bit_cast(float, ub); }
__device__ __forceinline__ float xmax32(float x) { float a, b; half_swap(x, a, b); return fmaxf(a, b); }
__device__ __forceinline__ float xsum32(float x) { float a, b; half_swap(x, a, b); return a + b; }
__device__ __forceinline__ float xoth32(float x, int g) { float a, b; half_swap(x, a, b); return g ? a : b; }
template <int D>
__device__ __forceinline__ void flash_tile_fast(FlashState<D>& st, const bf16x8 (&qf)[D / 16], const LAS unsigned char* Kt, int pk, const LAS unsigned char* Vt, int pv, float slope2, float c0, int lane) {
    const int r32 = lane & 31, g = lane >> 5;
    f32x16 s0, s1;
#pragma unroll
    for (int r = 0; r < 16; ++r) { const float kc = (float)((r & 3) + 8 * (r >> 2)); s0[r] = __builtin_fmaf(slope2, kc, c0); s1[r] = __builtin_fmaf(slope2, kc + 32.0f, c0); }
#pragma unroll
    for (int sb = 0; sb < D / 64; ++sb) {
        bf16x8 kf[8];
#pragma unroll
        for (int s = 0; s < 4; ++s) { kf[2 * s] = *(const LAS bf16x8*)(Kt + r32 * pk + (16 * (4 * sb + s) + 8 * g) * 2); kf[2 * s + 1] = *(const LAS bf16x8*)(Kt + (32 + r32) * pk + (16 * (4 * sb + s) + 8 * g) * 2); }
        asm volatile("" :: "v"(kf[0]), "v"(kf[1]), "v"(kf[2]), "v"(kf[3]), "v"(kf[4]), "v"(kf[5]), "v"(kf[6]), "v"(kf[7]));
#pragma unroll
        for (int s = 0; s < 4; ++s) { s0 = MFMA32(kf[2 * s], qf[4 * sb + s], s0); s1 = MFMA32(kf[2 * s + 1], qf[4 * sb + s], s1); }
    }
    v4u vf[2][2][D / 32];
#pragma unroll
    for (int kh = 0; kh < 2; ++kh)
#pragma unroll
        for (int sp = 0; sp < 2; ++sp)
#pragma unroll
            for (int t = 0; t < D / 32; ++t) {
                const LAS unsigned char* vrow = Vt + (32 * t + r32) * pv + (32 * kh + 16 * sp + 4 * g) * 2;
                const v2u lo = *(const LAS v2u*)vrow, hi = *(const LAS v2u*)(vrow + 16);
                vf[kh][sp][t].x = lo.x; vf[kh][sp][t].y = lo.y; vf[kh][sp][t].z = hi.x; vf[kh][sp][t].w = hi.y;
            }
    __builtin_amdgcn_sched_barrier(0);
    float mx = -1e30f;
#pragma unroll
    for (int r = 0; r < 16; ++r) mx = fmaxf(mx, fmaxf(s0[r], s1[r]));
    mx = xmax32(mx);
    const float mn = fmaxf(st.m, mx);
    if (__ballot(mn > st.m) != 0ull) { const float alpha = ex2(st.m - mn); st.l *= alpha;
#pragma unroll
        for (int t = 0; t < D / 32; ++t) st.o[t] = st.o[t] * alpha; }
    st.m = mn;
    float sum = 0.f;
#pragma unroll
    for (int r = 0; r < 16; ++r) { const float p0 = ex2(s0[r] - mn), p1 = ex2(s1[r] - mn); s0[r] = p0; s1[r] = p1; sum += p0 + p1; }
    st.l += sum;
#pragma unroll
    for (int kh = 0; kh < 2; ++kh)
#pragma unroll
        for (int sp = 0; sp < 2; ++sp) {
            float pp[8];
#pragma unroll
            for (int j = 0; j < 8; ++j) pp[j] = kh ? s1[8 * sp + j] : s0[8 * sp + j];
            const bf16x8 pb = pack8(pp);
#pragma unroll
            for (int t = 0; t < D / 32; ++t) st.o[t] = MFMA32(__builtin_bit_cast(bf16x8, vf[kh][sp][t]), pb, st.o[t]);
        }
}
template <int D, class F>
__device__ __forceinline__ void flash_tile(FlashState<D>& st, const bf16x8 (&qf)[D / 16], const LAS unsigned char* Kt, int pk, const LAS unsigned char* Vt, int pv, const F& f, int lane) {
    const int r32 = lane & 31, g = lane >> 5;
    f32x16 s0 = zero16(), s1 = zero16();
#pragma unroll
    for (int sb = 0; sb < D / 64; ++sb) {
        bf16x8 kf[8];
#pragma unroll
        for (int s = 0; s < 4; ++s) { kf[2 * s] = *(const LAS bf16x8*)(Kt + r32 * pk + (16 * (4 * sb + s) + 8 * g) * 2); kf[2 * s + 1] = *(const LAS bf16x8*)(Kt + (32 + r32) * pk + (16 * (4 * sb + s) + 8 * g) * 2); }
        asm volatile("" :: "v"(kf[0]), "v"(kf[1]), "v"(kf[2]), "v"(kf[3]), "v"(kf[4]), "v"(kf[5]), "v"(kf[6]), "v"(kf[7]));
#pragma unroll
        for (int s = 0; s < 4; ++s) { s0 = MFMA32(kf[2 * s], qf[4 * sb + s], s0); s1 = MFMA32(kf[2 * s + 1], qf[4 * sb + s], s1); }
    }
    float mx = -1e30f;
#pragma unroll
    for (int r = 0; r < 16; ++r) { bool v0, v1; const float x0 = f(s0[r], crow(r, g), v0), x1 = f(s1[r], 32 + crow(r, g), v1);
        s0[r] = v0 ? x0 : -1e30f; s1[r] = v1 ? x1 : -1e30f; mx = fmaxf(mx, fmaxf(s0[r], s1[r])); }
    mx = xmax32(mx);
    const float mn = fmaxf(st.m, mx), alpha = ex2(st.m - mn);
    float sum = 0.f;
#pragma unroll
    for (int r = 0; r < 16; ++r) { const float p0 = s0[r] > -1e29f ? ex2(s0[r] - mn) : 0.f, p1 = s1[r] > -1e29f ? ex2(s1[r] - mn) : 0.f; s0[r] = p0; s1[r] = p1; sum += p0 + p1; }
    st.l = st.l * alpha + sum; st.m = mn;
#pragma unroll
    for (int t = 0; t < D / 32; ++t) st.o[t] = st.o[t] * alpha;
#pragma unroll
    for (int kh = 0; kh < 2; ++kh) {
        v4u vf[2][D / 32];
#pragma unroll
        for (int sp = 0; sp < 2; ++sp)
#pragma unroll
            for (int t = 0; t < D / 32; ++t) {
                const LAS unsigned char* vrow = Vt + (32 * t + r32) * pv + (32 * kh + 16 * sp + 4 * g) * 2;
                const v2u lo = *(const LAS v2u*)vrow, hi = *(const LAS v2u*)(vrow + 16);
                vf[sp][t].x = lo.x; vf[sp][t].y = lo.y; vf[sp][t].z = hi.x; vf[sp][t].w = hi.y;
            }
#pragma unroll
        for (int sp = 0; sp < 2; ++sp)
#pragma unroll
            for (int t = 0; t < D / 32; ++t) asm volatile("" :: "v"(vf[sp][t]));
#pragma unroll
        for (int sp = 0; sp < 2; ++sp) {
            float pp[8];
#pragma unroll
            for (int j = 0; j < 8; ++j) pp[j] = kh ? s1[8 * sp + j] : s0[8 * sp + j];
            const bf16x8 pb = pack8(pp);
#pragma unroll
            for (int t = 0; t < D / 32; ++t) st.o[t] = MFMA32(__builtin_bit_cast(bf16x8, vf[sp][t]), pb, st.o[t]);
        }
    }
}

constexpr int NS_KB = 0, NS_VB = 18432, NS_CK = 36864, NS_CV = 55296, NS_OA = 72704, NS_US = 138240;
struct MaskF { int tq, kbase, selbit, wlim; float slope2;
    __device__ __forceinline__ float operator()(float s, int key, bool& valid) const { const int dist = tq - (kbase + key); valid = selbit && dist >= 0 && dist < wlim; return s - slope2 * (float)dist; } };
struct NoF { __device__ __forceinline__ float operator()(float s, int, bool& valid) const { valid = true; return s; } };

__device__ __forceinline__ void nsa_unit(int b, int h, int i, const bf16* P, const float* gate_b, const bf16* KCMP, const bf16* VCMPT, const bf16* VST, const bf16* VWT, bf16* ONSA,
                                         LAS unsigned char* lds, int tid, int wave, int lane) {
    const int r32 = lane & 31, g = lane >> 5, ql = r32 >> 2, gq = r32 & 3, hq = 4 * h + gq;
    const int tq = 64 * i + 8 * wave + ql;
    const size_t row = (size_t)b * SEQ + tq;
    bf16x8 qf[4];
#pragma unroll
    for (int s = 0; s < 4; ++s) qf[s] = *(const bf16x8*)(P + row * PLD + COL_QA + hq * 64 + 16 * s + 8 * g);
    float gate[3];
#pragma unroll
    for (int k = 0; k < 3; ++k) gate[k] = sigmoid_f(bf2f(P[row * PLD + COL_GATE + hq * 3 + k]) + gate_b[hq * 3 + k]);
    const float slope2 = ex2(-(float)(hq + 1)) * LOG2E;
    const bf16* Kslc = P + (size_t)b * SEQ * PLD + COL_KS + h * 64; const bf16* Kwin = P + (size_t)b * SEQ * PLD + COL_KW + h * 64;
    const bf16* Vslc = VST + (size_t)(b * 2 + h) * 64 * SEQ; const bf16* Vwin = VWT + (size_t)(b * 2 + h) * 64 * SEQ;
    const int jw0 = i > 4 ? i - 4 : 0;
    const int srow = tid >> 3, sch = tid & 7;
#define NS_LOAD(td, rk, rv) do { const int td_ = (td); const bool w_ = (td_ >> 8) != 0; const int j_ = td_ & 255; \
        rk = *(const v4u*)((w_ ? Kwin : Kslc) + (size_t)(64 * j_ + srow) * PLD + 8 * sch); rv = *(const v4u*)((w_ ? Vwin : Vslc) + (size_t)srow * SEQ + 64 * j_ + 8 * sch); } while (0)
#define NS_STORE(buf, rk, rv) do { *(LAS v4u*)(lds + NS_KB + (buf) * 9216 + srow * 144 + sch * 16) = rk; *(LAS v4u*)(lds + NS_VB + (buf) * 9216 + srow * 144 + sch * 16) = rv; } while (0)
#define NS_NEXT(rem, wj, td) do { if (rem) { const int j_ = 31 - __builtin_clz(rem); rem &= ~(1u << j_); td = j_; } else if (wj >= jw0) { td = wj | 256; --wj; } else td = -1; } while (0)
    v4u rk, rv;
    NS_LOAD(i, rk, rv);
    LAS unsigned* usel_w = (LAS unsigned*)(lds + NS_US);
    if (tid == 0) *usel_w = 0u;
    {
        const bf16* kc = KCMP + (size_t)(b * 2 + h) * 128 * 64; const bf16* vc = VCMPT + (size_t)(b * 2 + h) * 64 * 128;
#pragma unroll
        for (int k = 0; k < 2; ++k) { const int id = tid + 512 * k;
            *(LAS v4u*)(lds + NS_CK + (id >> 3) * 144 + (id & 7) * 16) = *(const v4u*)(kc + (size_t)(id >> 3) * 64 + 8 * (id & 7));
            *(LAS v4u*)(lds + NS_CV + (id >> 4) * 272 + (id & 15) * 16) = *(const v4u*)(vc + (size_t)(id >> 4) * 128 + 8 * (id & 15)); }
    }
    NS_STORE(0, rk, rv);
    __syncthreads();
    LAS float* oa = (LAS float*)(lds + NS_OA + wave * 8192) + lane;
    unsigned sel;
    {
        f32x16 S[4];
#pragma unroll
        for (int kh = 0; kh < 4; ++kh) { S[kh] = zero16();
            if (32 * kh <= 4 * i + 2) {
                bf16x8 kf[4];
#pragma unroll
                for (int s = 0; s < 4; ++s) kf[s] = *(const LAS bf16x8*)(lds + NS_CK + (32 * kh + r32) * 144 + (16 * s + 8 * g) * 2);
                asm volatile("" :: "v"(kf[0]), "v"(kf[1]), "v"(kf[2]), "v"(kf[3]));
#pragma unroll
                for (int s = 0; s < 4; ++s) S[kh] = MFMA32(kf[s], qf[s], S[kh]); } }
        float mx = -1e30f;
#pragma unroll
        for (int kh = 0; kh < 4; ++kh) if (32 * kh <= 4 * i + 2) {
#pragma unroll
            for (int r = 0; r < 16; ++r) { const int n = 32 * kh + crow(r, g), dist = tq - (16 * n + 31); const float x = S[kh][r] - slope2 * (float)dist;
                S[kh][r] = dist >= 0 ? x : -1e30f; mx = fmaxf(mx, S[kh][r]); } }
        mx = xmax32(mx);
        float lsum = 0.f;
#pragma unroll
        for (int kh = 0; kh < 4; ++kh) if (32 * kh <= 4 * i + 2) {
#pragma unroll
            for (int r = 0; r < 16; ++r) { const float e = S[kh][r] > -1e29f ? ex2(S[kh][r] - mx) : 0.f; S[kh][r] = e; lsum += e; } }
        lsum = xsum32(lsum);
        const float inv = lsum > 0.f ? 1.0f / lsum : 0.f;
#pragma unroll
        for (int kh = 0; kh < 4; ++kh) S[kh] = S[kh] * inv;
        float A[16], C[16];
#pragma unroll
        for (int kh = 0; kh < 4; ++kh)
#pragma unroll
            for (int m = 0; m < 4; ++m) { const float p3 = S[kh][4 * m + 3]; A[4 * kh + m] = (S[kh][4 * m] + S[kh][4 * m + 1]) + (S[kh][4 * m + 2] + 0.5f * p3); C[4 * kh + m] = 0.5f * p3; }
        f32x16 O[2]; O[0] = zero16(); O[1] = zero16();
#pragma unroll
        for (int kh = 0; kh < 4; ++kh) if (32 * kh <= 4 * i + 2)
#pragma unroll
            for (int sp = 0; sp < 2; ++sp) { float pp[8];
#pragma unroll
                for (int j = 0; j < 8; ++j) pp[j] = S[kh][8 * sp + j];
                const bf16x8 pb = pack8(pp);
                v4u vf[2];
#pragma unroll
                for (int t = 0; t < 2; ++t) { const LAS unsigned char* vrow = lds + NS_CV + (32 * t + r32) * 272 + (32 * kh + 16 * sp + 4 * g) * 2;
                    const v2u lo = *(const LAS v2u*)vrow, hi = *(const LAS v2u*)(vrow + 16); vf[t].x = lo.x; vf[t].y = lo.y; vf[t].z = hi.x; vf[t].w = hi.y; }
                asm volatile("" :: "v"(vf[0]), "v"(vf[1]));
#pragma unroll
                for (int t = 0; t < 2; ++t) O[t] = MFMA32(__builtin_bit_cast(bf16x8, vf[t]), pb, O[t]); }
#pragma unroll
        for (int t = 0; t < 2; ++t)
#pragma unroll
            for (int r = 0; r < 16; ++r) oa[(16 * t + r) * 64] = O[t][r] * gate[0];
        __builtin_amdgcn_sched_barrier(0);
#pragma unroll
        for (int k = 0; k < 16; ++k) { A[k] += dppf<0xB1>(A[k]); A[k] += dppf<0x4E>(A[k]); C[k] += dppf<0xB1>(C[k]); C[k] += dppf<0x4E>(C[k]); }
        float own[16];
        {   float Co[16];
#pragma unroll
            for (int k = 0; k < 16; ++k) Co[k] = xoth32(C[k], g);
#pragma unroll
            for (int k = 0; k < 16; ++k) { const float prev = k > 0 ? Co[k - 1] : 0.f; own[k] = A[k] + (g ? Co[k] : prev); } }
        float imp[32];
#pragma unroll
        for (int k = 0; k < 16; ++k) { const float oth = xoth32(own[k], g); imp[2 * k] = g ? oth : own[k]; imp[2 * k + 1] = g ? own[k] : oth; }
        sel = 1u | (1u << i) | ((1u << i) >> 1);
        if (i < 8) sel = 0xffu;
        else {
            int key[32];
#pragma unroll
            for (int j = 0; j < 32; ++j) { const int kb = (int)((__builtin_bit_cast(unsigned, imp[j]) & ~31u) | (unsigned)(31 - j)); key[j] = (j >= 1 && j <= i - 2) ? kb : (int)0x80000000; }
#pragma unroll 1
            for (int it = 0; it < 5; ++it) {
                int b0 = key[0];
#pragma unroll
                for (int j = 1; j < 32; ++j) b0 = key[j] > b0 ? key[j] : b0;
                sel |= 1u << (31 - (b0 & 31));
#pragma unroll
                for (int j = 0; j < 32; ++j) key[j] = key[j] == b0 ? (int)0x80000000 : key[j];
            }
        }
        sel &= (i >= 31) ? 0xffffffffu : ((2u << i) - 1u);
    }
    {   unsigned u = sel;
#pragma unroll
        for (int o = 1; o < 64; o <<= 1) u |= (unsigned)__shfl_xor((int)u, o);
        if (lane == 0) __hip_atomic_fetch_or(usel_w, u, __ATOMIC_RELAXED, __HIP_MEMORY_SCOPE_WORKGROUP); }
    __syncthreads();
    unsigned rem = (unsigned)__builtin_amdgcn_readfirstlane((int)*usel_w);
    int wj = i, tdc, tdn, tdp;
    rem &= ~(1u << i); tdc = i;
    NS_NEXT(rem, wj, tdn);
    if (tdn >= 0) NS_LOAD(tdn, rk, rv);
    FlashState<64> st; flash_reset(st);
    bool in_win = false;
    for (int ts = 0; tdc >= 0; ++ts) {
        const bool w = (tdc >> 8) != 0; const int j = tdc & 255;
        if (w && !in_win) {
            in_win = true;
            const float lt = xsum32(st.l), sc = lt > 0.f ? gate[1] / lt : 0.f;
#pragma unroll
            for (int t = 0; t < 2; ++t)
#pragma unroll
                for (int r = 0; r < 16; ++r) oa[(16 * t + r) * 64] += st.o[t][r] * sc;
            flash_reset(st);
        }
        const LAS unsigned char* Kt = lds + NS_KB + (ts & 1) * 9216; const LAS unsigned char* Vt = lds + NS_VB + (ts & 1) * 9216;
        {
            const int selbit = w ? 1 : (int)((sel >> j) & 1u);
            if (__ballot(selbit) != 0ull) {
                if (j == i || (w && j == i - 4)) { const MaskF f{tq, 64 * j, selbit, w ? 256 : (1 << 30), slope2}; flash_tile<64>(st, qf, Kt, 144, Vt, 144, f, lane); }
                else {
                    flash_tile_fast<64>(st, qf, Kt, 144, Vt, 144, slope2, (selbit ? 0.f : -1e30f) - slope2 * (float)(tq - 64 * j - 4 * g), lane); }
            }
        }
        NS_NEXT(rem, wj, tdp);
        if (tdn >= 0) NS_STORE((ts + 1) & 1, rk, rv);
        __syncthreads();
        if (tdp >= 0) NS_LOAD(tdp, rk, rv);
        tdc = tdn; tdn = tdp;
    }
    {   const float lt = xsum32(st.l), sc = lt > 0.f ? gate[2] / lt : 0.f;
#pragma unroll
        for (int t = 0; t < 2; ++t)
#pragma unroll
            for (int r = 0; r < 16; ++r) st.o[t][r] = oa[(16 * t + r) * 64] + st.o[t][r] * sc; }
    bf16* op = ONSA + row * 512 + hq * 64 + 4 * g;
#pragma unroll
    for (int t = 0; t < 2; ++t)
#pragma unroll
        for (int rq = 0; rq < 4; ++rq) { v2u w; w.x = pk2(st.o[t][4 * rq], st.o[t][4 * rq + 1]); w.y = pk2(st.o[t][4 * rq + 2], st.o[t][4 * rq + 3]); *(v2u*)(op + 32 * t + 8 * rq) = w; }
#undef NS_LOAD
#undef NS_STORE
#undef NS_NEXT
}

constexpr int XA_K = 0, XA_V = 69632;
__device__ __forceinline__ void xattn_item(int item, const bf16* XQ, const bf16* MEMKV, const bf16* MEMVT, bf16* XO, LAS unsigned char* lds, int tid, int wave, int lane) {
    const int bh = item >> 1, half = item & 1, b = bh >> 2, h = bh & 3;
    const int r32 = lane & 31, g = lane >> 5;
    {
        const bf16* ks = MEMKV + (size_t)(b * MEM_LEN) * 1024 + h * 128; const bf16* vs = MEMVT + (size_t)bh * 128 * 256;
#pragma unroll
        for (int k = 0; k < 8; ++k) { const int id = tid + 512 * k;
            *(LAS v4u*)(lds + XA_K + (id >> 4) * 272 + (id & 15) * 16) = *(const v4u*)(ks + (size_t)(id >> 4) * 1024 + 8 * (id & 15));
            *(LAS v4u*)(lds + XA_V + (id >> 5) * 528 + (id & 31) * 16) = *(const v4u*)(vs + (size_t)(id >> 5) * 256 + 8 * (id & 31)); }
    }
    __syncthreads();
    for (int qt = 4 * half; qt < 4 * half + 4; ++qt) {
        const size_t row = (size_t)b * SEQ + 256 * qt + 32 * wave + r32;
        bf16x8 qf[8];
#pragma unroll
        for (int s = 0; s < 8; ++s) qf[s] = *(const bf16x8*)(XQ + row * 512 + h * 128 + 16 * s + 8 * g);
        FlashState<128> st; flash_reset(st);
        const NoF f{};
#pragma unroll 1
        for (int kt = 0; kt < 4; ++kt) flash_tile<128>(st, qf, lds + XA_K + kt * 64 * 272, 272, lds + XA_V + kt * 128, 528, f, lane);
        const float lt = xsum32(st.l), sc = 1.0f / lt;
        bf16* op = XO + row * 512 + h * 128 + 4 * g;
#pragma unroll
        for (int t = 0; t < 4; ++t)
#pragma unroll
            for (int rq = 0; rq < 4; ++rq) { v2u w; w.x = pk2(st.o[t][4 * rq] * sc, st.o[t][4 * rq + 1] * sc); w.y = pk2(st.o[t][4 * rq + 2] * sc, st.o[t][4 * rq + 3] * sc); *(v2u*)(op + 32 * t + 8 * rq) = w; }
    }
    __syncthreads();
}
#define XB_TMO      128
#define XB_XCNT(j)  (256  + 64 * (j))
#define XB_XSUB(j)  (1280 + 64 * (j))
#define XB_XGEN(j)  (2304 + 64 * (j))
#define XB_TOP      3328
#define XB_TOPGEN   3392
#define XCD_BAR_WORDS 3456
#define XB_SPIN_CAP (1u << 18)

__device__ __forceinline__ unsigned xb_ld(unsigned* p)              { return __hip_atomic_load(p, __ATOMIC_RELAXED, __HIP_MEMORY_SCOPE_AGENT); }
__device__ __forceinline__ unsigned xb_add(unsigned* p, unsigned v) { return __hip_atomic_fetch_add(p, v, __ATOMIC_RELAXED, __HIP_MEMORY_SCOPE_AGENT); }
__device__ __forceinline__ unsigned xb_xcc_id() { return (unsigned)__builtin_amdgcn_s_getreg((3 << 11) | 20) & 0xFu; }
#define XB_SPIN(cond, bar) do { unsigned _sp = 0; while (cond) { __builtin_amdgcn_s_sleep(1); \
    if ((++_sp & 255u) == 0u) { if (xb_ld(&(bar)[XB_TMO])) break; if (_sp > XB_SPIN_CAP) { atomicAdd(&(bar)[XB_TMO], 1u); break; } } } } while (0)

struct XcdBarrier {
    unsigned* bar; unsigned x;
    volatile LAS unsigned* st;
};

__device__ __forceinline__ XcdBarrier xcd_barrier_post(unsigned* bar, volatile LAS unsigned* st) {
    XcdBarrier b; b.bar = bar; b.x = xb_xcc_id(); b.st = st;
    if (threadIdx.x == 0) (void)xb_add(&bar[XB_XCNT(b.x)], 1u);
    return b;
}
__device__ __forceinline__ void xcd_barrier_complete(unsigned* bar, unsigned x, unsigned& nloc, unsigned& nx) {
    const unsigned G = gridDim.x * gridDim.y * gridDim.z;
    unsigned sum, cnt, mine, sp = 0u;
    for (;;) {
        sum = 0u; cnt = 0u; mine = 0u;
#pragma unroll
        for (unsigned j = 0; j < 16; ++j) { const unsigned c = xb_ld(&bar[XB_XCNT(j)]); sum += c; cnt += (c > 0u) ? 1u : 0u; mine = (j == x) ? c : mine; }
        if (sum == G) break;
        __builtin_amdgcn_s_sleep(1);
        if ((++sp & 255u) == 0u) { if (xb_ld(&bar[XB_TMO])) break; if (sp > XB_SPIN_CAP) { atomicAdd(&bar[XB_TMO], 1u); break; } }
    }
    nloc = mine > 0u ? mine : 1u; nx = cnt > 0u ? cnt : 1u;
}

__device__ __forceinline__ void xcd_barrier(const XcdBarrier& b) {
    asm volatile("s_waitcnt vmcnt(0)" ::: "memory");
    __syncthreads();
    if (threadIdx.x == 0) {
        unsigned* bar = b.bar;
        __builtin_amdgcn_s_waitcnt(0);
        unsigned nloc = b.st[0], nx = b.st[1];
        if (nloc == 0u) { xcd_barrier_complete(bar, b.x, nloc, nx); b.st[0] = nloc; b.st[1] = nx; }
        const unsigned old = xb_add(&bar[XB_XSUB(b.x)], 1u);
        const unsigned gen = old / nloc;
        if (old + 1u == (gen + 1u) * nloc) {
            __builtin_amdgcn_fence(__ATOMIC_RELEASE, "agent");
            asm volatile("s_waitcnt vmcnt(0)" ::: "memory");
            const unsigned og = xb_add(&bar[XB_TOP], 1u);
            const unsigned tg = og / nx;
            if (og + 1u == (tg + 1u) * nx) xb_add(&bar[XB_TOPGEN], 1u);
            else XB_SPIN(xb_ld(&bar[XB_TOPGEN]) == tg, bar);
            __builtin_amdgcn_fence(__ATOMIC_ACQUIRE, "agent");
            xb_add(&bar[XB_XGEN(b.x)], 1u);
            asm volatile("s_waitcnt vmcnt(0)" ::: "memory");
        } else {
            XB_SPIN(xb_ld(&bar[XB_XGEN(b.x)]) == gen, bar);
            __builtin_amdgcn_fence(__ATOMIC_ACQUIRE, "agent");
            asm volatile("s_waitcnt vmcnt(0)" ::: "memory");
        }
    }
    __syncthreads();
}

struct Args { const float* in[28]; float* out; unsigned char* ws; };
enum { I_X = 0, I_MEM, I_LN_MIX_G, I_W_IN, I_NSA_GATE_B, I_CMP_POS_K, I_CMP_W1_K, I_CMP_W2_K, I_CMP_POS_V, I_CMP_W1_V, I_CMP_W2_V, I_GLA_W_ALPHA2, I_GLA_B_ALPHA, I_GLA_NORM_G,
       I_W_BRANCH_NSA, I_W_BRANCH_GLA, I_W_OUT, I_LN_X_G, I_LN_MEM_G, I_W_XQ, I_W_XKV, I_W_XO, I_LN_FFN_G, I_W_UP, I_CONV_W, I_CONV_B, I_W_DOWN, I_LN_FINAL_G };


__global__ void __launch_bounds__(NTHREADS, 2) fwd_kernel(Args args) {
    extern __shared__ __attribute__((aligned(16))) unsigned char lds_raw[];
    cg::grid_group grid = cg::this_grid();
    LAS unsigned char* lds = (LAS unsigned char*)lds_raw;
    const int tid = threadIdx.x, lane = tid & 63, wave = __builtin_amdgcn_readfirstlane(tid >> 6);
    const int G = gridDim.x, bx = blockIdx.x;
    const int gw = bx * NWAVES + wave, NGW = G * NWAVES;
    const int gtid = bx * NTHREADS + tid, NTH = G * NTHREADS;
    unsigned char* ws = args.ws;
    bf16* WIN_T = (bf16*)(ws + WS_WIN); bf16* WUP_T = (bf16*)(ws + WS_WUP); bf16* WDOWN_T = (bf16*)(ws + WS_WDOWN); bf16* WXKV_T = (bf16*)(ws + WS_WXKV); bf16* WOUT_T = (bf16*)(ws + WS_WOUT);
    bf16* WBN_T = (bf16*)(ws + WS_WBN); bf16* WBG_T = (bf16*)(ws + WS_WBG); bf16* WXQ_T = (bf16*)(ws + WS_WXQ); bf16* WXO_T = (bf16*)(ws + WS_WXO);
    bf16* W1K_T = (bf16*)(ws + WS_W1K); bf16* W1V_T = (bf16*)(ws + WS_W1V); bf16* W2K_T = (bf16*)(ws + WS_W2K); bf16* W2V_T = (bf16*)(ws + WS_W2V); float* C1 = (float*)(ws + WS_C1);
    bf16* XN0 = (bf16*)(ws + WS_XN0); bf16* XN = (bf16*)(ws + WS_XN); bf16* VST = (bf16*)(ws + WS_VST); bf16* VWT = (bf16*)(ws + WS_VWT); bf16* KCMP = (bf16*)(ws + WS_KCMP); bf16* VCMPT = (bf16*)(ws + WS_VCMPT);
    bf16* MIX = (bf16*)(ws + WS_MIX);
    unsigned char* G8 = ws + WS_G8;
    bf16* P = (bf16*)(ws + WS_P); bf16* XQ = (bf16*)(ws + WS_XQ); bf16* XO = (bf16*)(ws + WS_XO); bf16* ACT = (bf16*)(ws + WS_ACT);
    bf16* MEMN = (bf16*)(ws + WS_MEMN); bf16* MEMKV = (bf16*)(ws + WS_MEMKV); bf16* ONSA = (bf16*)(ws + WS_ONSA); bf16* OGLA = (bf16*)(ws + WS_OGLA);
    bf16* MEMVT = (bf16*)(ws + WS_MEMVT2);
    float* SIDE_U = (float*)(ws + WS_SIDEU); float* SIDE_G = (float*)(ws + WS_SIDEG);
    float* ROWSS1 = (float*)(ws + WS_ROWSS); float* ROWSS2 = ROWSS1 + T; float* ROWSS3 = ROWSS2 + T;
    float* out = args.out;
    const float* x = args.in[I_X];
    if (tid < 16) ((LAS unsigned*)(lds + LDS_BYTES - 64))[tid] = 0u;
    __syncthreads();
    const XcdBarrier xbar = xcd_barrier_post((unsigned*)(ws + WS_CTL) + 4096, (volatile LAS unsigned*)(lds + LDS_BYTES - 64));
#define GRID_SYNC() xcd_barrier(xbar)

    {
        LAS float* scr = (LAS float*)(lds + wave * 16384);
        const float* w_in = args.in[I_W_IN];
        constexpr int J0 = 16 * 16, J1 = 16 * 24, J2 = 16 * 8, J3 = 16 * 40, J4 = 16 * 64;
        constexpr int J5 = 16 * 32, J6 = 8 * 32, J7 = 8 * 32, J8 = 16 * 32, J9 = 16 * 16, J10 = 8 * 32;
        constexpr int J11 = 16 * 176, J12 = 44 * 32;
        constexpr int J13 = 32 * 4, J14 = 32 * 4, J15 = 2 * 2, J16 = 2 * 2;
        constexpr int NITEMS = J0 + J1 + J2 + J3 + J4 + J5 + J6 + J7 + J8 + J9 + J10 + J11 + J12 + J13 + J14 + J15 + J16;
        for (int it = gw; it < NITEMS; it += NGW) {
            int r = it;
            if (r < J0) { transpose_item(w_in + 0, IN_W, DM, 512, WIN_T, COL_QA, 0.125f * LOG2E, scr, r, lane); continue; } r -= J0;
            if (r < J1) { transpose_item(w_in + 512, IN_W, DM, 768, WIN_T, COL_KC, 1.0f, scr, r, lane); continue; } r -= J1;
            if (r < J2) { transpose_item(w_in + 1304, IN_W, DM, 256, WIN_T, COL_QB, 0.125f, scr, r, lane); continue; } r -= J2;
            if (r < J3) { transpose_item(w_in + 1560, IN_W, DM, 1280, WIN_T, COL_KB, 1.0f, scr, r, lane); continue; } r -= J3;
            if (r < J4) { transpose_item(w_in + 2856, IN_W, DM, 2048, WIN_T, WROW_GN, 1.0f, scr, r, lane); continue; } r -= J4;
            if (r < J5) { transpose_item(args.in[I_W_XKV], 1024, DM, 1024, WXKV_T, 0, 1.0f, scr, r, lane); continue; } r -= J5;
            if (r < J6) { transpose_item(args.in[I_W_BRANCH_NSA], 1024, 512, 1024, WBN_T, 0, 1.0f, scr, r, lane); continue; } r -= J6;
            if (r < J7) { transpose_item(args.in[I_W_BRANCH_GLA], 1024, 512, 1024, WBG_T, 0, 1.0f, scr, r, lane); continue; } r -= J7;
            if (r < J8) { transpose_item(args.in[I_W_OUT], 1024, DM, 1024, WOUT_T, 0, 1.0f, scr, r, lane); continue; } r -= J8;
            if (r < J9) { transpose_item(args.in[I_W_XQ], 512, DM, 512, WXQ_T, 0, 0.08838834764831845f * LOG2E, scr, r, lane, args.in[I_LN_X_G]); continue; } r -= J9;
            if (r < J10) { transpose_item(args.in[I_W_XO], 1024, 512, 1024, WXO_T, 0, 1.0f, scr, r, lane); continue; } r -= J10;
            if (r < J11) { const int job = r >> 6, pn = job >> 1, isg = job & 1;
                transpose_item(args.in[I_W_UP] + (isg ? FFN : 0) + 128 * pn, FFN2, DM, 128, WUP_T, 256 * pn + 128 * isg, 1.0f, scr, r & 63, lane, args.in[I_LN_FFN_G]); continue; } r -= J11;
            if (r < J12) { transpose_item(args.in[I_W_DOWN], DM, FFN, DM, WDOWN_T, 0, 1.0f, scr, r, lane); continue; } r -= J12;
            if (r < J13) { transpose_item(args.in[I_CMP_W1_K], 128, 2048, 128, W1K_T, 0, 1.0f, scr, r, lane); continue; } r -= J13;
            if (r < J14) { transpose_item(args.in[I_CMP_W1_V], 128, 2048, 128, W1V_T, 0, 1.0f, scr, r, lane); continue; } r -= J14;
            if (r < J15) { transpose_item(args.in[I_CMP_W2_K], 64, 128, 64, W2K_T, 0, 1.0f, scr, r, lane); continue; } r -= J15;
            transpose_item(args.in[I_CMP_W2_V], 64, 128, 64, W2V_T, 0, 1.0f, scr, r, lane);
        }
        for (int idx = gtid; idx < 256 * 1024; idx += NTH) {
            const int rowi = WROW_TAIL + (idx >> 10), k = idx & 1023;
            const int col = rowi < WROW_ALPHA ? 1280 + (rowi - WROW_TAIL) : (rowi < IN_W ? 2840 + (rowi - WROW_ALPHA) : -1);
            WIN_T[(size_t)rowi * DM + k] = col >= 0 ? (bf16)f2bf(w_in[(size_t)k * IN_W + col]) : (bf16)0;
        }
        if (wave == 0) for (int o = bx; o < 256; o += G) {
            const int kv = o >> 7, j = o & 127; const float* pe = args.in[kv ? I_CMP_POS_V : I_CMP_POS_K]; const float* w1 = args.in[kv ? I_CMP_W1_V : I_CMP_W1_K];
            float pv[32], wv[32];
#pragma unroll
            for (int i = 0; i < 32; ++i) { pv[i] = pe[lane + 64 * i]; wv[i] = w1[(size_t)(lane + 64 * i) * 128 + j]; }
            float s = 0.f;
#pragma unroll
            for (int i = 0; i < 32; ++i) s += pv[i] * wv[i];
            s = wave_sum(s);
            if (lane == 0) C1[o] = s;
        }
        rms_rows_bf16(x, args.in[I_LN_MIX_G], XN0, T, gw, NGW, lane);
        rms_rows_bf16(args.in[I_MEM], args.in[I_LN_MEM_G], MEMN, TM, gw, NGW, lane);
    }
    grid.sync();
    {
        pg8::Gemm g{XN0, WIN_T, T, NWIN, DM}; pg8::StaticOrder S; S.init(T, NWIN, G, bx);
        pg8::EpiWin E{P, PLD, G8, G8LD};
        pg8::gemm_phase<pg8::EpiWin, pg8::StaticOrder, true, true>(lds, g, S, E);
    }
    GRID_SYNC();
    {
        LAS bf16* scr = (LAS bf16*)(lds + wave * 16384);
        for (int it = gw; it < 4096; it += NGW) {
            const int w = it >> 11, r = it & 2047, bh = r >> 5, tt = r & 31, b = bh >> 1, h = bh & 1;
            transpose_tile64(P + (size_t)(b * SEQ + 64 * tt) * PLD + (w ? COL_VW : COL_VS) + h * 64, PLD, (w ? VWT : VST) + (size_t)bh * 64 * SEQ + 64 * tt, SEQ, scr, lane);
        }
        __syncthreads();
        {
            const int ncw = G >= 256 ? 128 : G, gm = G >= 256 ? 128 : G, cm = G >= 256 ? bx - 128 : bx;
            if (bx < ncw) for (int u = bx; u < 128; u += ncw) { const int kv = u >> 6, b = (u >> 1) & 31, h = u & 1;
                compress_unit(kv, b, h, P, kv ? W1V_T : W1K_T, C1 + 128 * kv, kv ? W2V_T : W2K_T, kv ? VCMPT : KCMP, lds, wave, lane); }
            if (cm >= 0) {
                pg8::Gemm g{MEMN, WXKV_T, TM, 1024, DM}; pg8::StaticOrder S; S.init(TM, 1024, gm, cm);
                pg8::EpiBf16<0> E{MEMKV, 1024, nullptr, 0, 0, 1.f};
                pg8::gemm_phase<pg8::EpiBf16<0>, pg8::StaticOrder, true, true>(lds, g, S, E);
            }
        }
    }
    GRID_SYNC();
    {
        LAS bf16* scr = (LAS bf16*)(lds + wave * 16384);
        for (int r = gw; r < 1024; r += NGW) { const int bh = r >> 3, mt = (r >> 1) & 3, dh = r & 1, b = bh >> 2, h = bh & 3;
            transpose_tile64(MEMKV + (size_t)(b * MEM_LEN + 64 * mt) * 1024 + 512 + h * 128 + 64 * dh, 1024, MEMVT + ((size_t)bh * 128 + 64 * dh) * 256 + 64 * mt, 256, scr, lane); }
        __syncthreads();
    }
    {
        unsigned* qctr = (unsigned*)(ws + WS_CTL) + 32;
        volatile LAS int* qslot = (volatile LAS int*)(lds + NS_US + 32);
        if (tid == 0) qslot[0] = (int)__hip_atomic_fetch_add(qctr, 1u, __ATOMIC_RELAXED, __HIP_MEMORY_SCOPE_AGENT);
        __syncthreads();
        int cur = __builtin_amdgcn_readfirstlane(qslot[0]);
#pragma unroll 1
        for (int it = 0; cur < 2048; ++it) {
            if (tid == 0) qslot[(it + 1) & 1] = (int)__hip_atomic_fetch_add(qctr, 1u, __ATOMIC_RELAXED, __HIP_MEMORY_SCOPE_AGENT);
            const int i = 31 - (cur >> 6), bh = cur & 63;
            nsa_unit(bh >> 1, bh & 1, i, P, args.in[I_NSA_GATE_B], KCMP, VCMPT, VST, VWT, ONSA, lds, launder(tid), wave, lane);
            __syncthreads();
            cur = __builtin_amdgcn_readfirstlane(qslot[(it + 1) & 1]);
        }
    }
    for (int item = bx; item < 256; item += G) gla_seq(item, P, args.in[I_GLA_W_ALPHA2], args.in[I_GLA_B_ALPHA], args.in[I_GLA_NORM_G], OGLA, lds, launder(tid), wave, lane);
    GRID_SYNC();
    {
        pg8::StaticOrder S; S.init(T, DM, G, bx);
        { pg8::Gemm g{ONSA, WBN_T, T, DM, 512}; pg8::EpiGate E{G8, G8LD, MIX, DM, 0}; pg8::gemm_phase<pg8::EpiGate, pg8::StaticOrder, true, true>(lds, g, S, E); }
        { pg8::Gemm g{OGLA, WBG_T, T, DM, 512}; pg8::EpiGate E{G8 + 1024, G8LD, MIX, DM, 1}; pg8::gemm_phase<pg8::EpiGate, pg8::StaticOrder, true, true>(lds, g, S, E); }
    }
    GRID_SYNC();
    {
        pg8::Gemm g{MIX, WOUT_T, T, DM, DM}; pg8::StaticOrder S; S.init(T, DM, G, bx);
        typedef pg8::EpiResT<false, false, true> EpiT; EpiT E{x, nullptr, DM, XN, ROWSS1};
        pg8::gemm_phase<EpiT, pg8::StaticOrder, true, true>(lds, g, S, E);
    }
    GRID_SYNC();
    {
        pg8::Gemm g{XN, WXQ_T, T, 512, DM}; pg8::StaticOrder S; S.init(T, 512, G, bx);
        pg8::EpiBf16RS E{XQ, 512, ROWSS1, 1.0f / DM, RMS_EPS};
        pg8::gemm_phase<pg8::EpiBf16RS, pg8::StaticOrder, true, true>(lds, g, S, E);
    }
    GRID_SYNC();
    for (int item = bx; item < 256; item += G) xattn_item(item, XQ, MEMKV, MEMVT, XO, lds, launder(tid), wave, lane);
    GRID_SYNC();
    {
        pg8::Gemm g{XO, WXO_T, T, DM, 512}; pg8::StaticOrder S; S.init(T, DM, G, bx);
        typedef pg8::EpiResT<true, false, true> EpiT; EpiT E{nullptr, nullptr, DM, XN, ROWSS2};
        pg8::gemm_phase<EpiT, pg8::StaticOrder, true, true>(lds, g, S, E);
    }
    GRID_SYNC();
    {
        pg8::Gemm g{XN, WUP_T, T, FFN2, DM}; pg8::StaticOrder S; S.init(T, FFN2, G, bx);
        pg8::EpiFfnAct E{ACT, FFN, args.in[I_CONV_W], args.in[I_CONV_B], FFN, SIDE_U, SIDE_G, (LAS float*)(lds + 131072), ROWSS2, 1.0f / DM, RMS_EPS};
        pg8::gemm_phase<pg8::EpiFfnAct, pg8::StaticOrder, true, true>(lds, g, S, E);
    }
    GRID_SYNC();
    ffn_fixup(SIDE_U, SIDE_G, args.in[I_CONV_W], args.in[I_CONV_B], ACT, gtid, NTH);
    GRID_SYNC();
    if (G == 256) {
        pg8::Gemm g{ACT, WDOWN_T, T, DM, FFN}; pg8::StaticOrder S; S.init(T, DM, G, bx);
        pg8::EpiFinalNorm E{XN, out, DM, args.in[I_LN_FINAL_G], (float*)(ws + WS_FSLOT), (unsigned*)ROWSS3, (unsigned*)(ws + WS_CTL) + 16, (LAS float*)(lds + 131072), 1.0f / DM, RMS_EPS};
        pg8::gemm_phase<pg8::EpiFinalNorm, pg8::StaticOrder, true, true>(lds, g, S, E);
    } else {
        {
            pg8::Gemm g{ACT, WDOWN_T, T, DM, FFN}; pg8::StaticOrder S; S.init(T, DM, G, bx);
            typedef pg8::EpiResT<true, false, true> EpiT; EpiT E{nullptr, nullptr, DM, XN, ROWSS3};
            pg8::gemm_phase<EpiT, pg8::StaticOrder, true, true>(lds, g, S, E);
        }
        GRID_SYNC();
        final_norm_rows(XN, ROWSS3, args.in[I_LN_FINAL_G], out, gtid, NTH);
    }
}

extern "C" void kernel_launch(void* const* d_in, const int* in_sizes, int n_in, void* d_out, int out_size, void* d_ws, size_t ws_size, hipStream_t stream) {
    static int grid = 0;
    if (grid == 0) {
        if (n_in != 28 || out_size != T * DM || ws_size < WS_END) { fprintf(stderr, "kernel_launch: unexpected shapes n_in %d out %d ws %zu\n", n_in, out_size, ws_size); grid = -1; return; }
        int dev = 0, cus = 0, per_cu = 0;
        if (hipGetDevice(&dev) != hipSuccess || hipDeviceGetAttribute(&cus, hipDeviceAttributeMultiprocessorCount, dev) != hipSuccess) { grid = -1; return; }
        if (hipFuncSetAttribute((const void*)fwd_kernel, hipFuncAttributeMaxDynamicSharedMemorySize, LDS_BYTES) != hipSuccess) { fprintf(stderr, "kernel_launch: hipFuncSetAttribute failed\n"); grid = -1; return; }
        if (hipOccupancyMaxActiveBlocksPerMultiprocessor(&per_cu, (const void*)fwd_kernel, NTHREADS, LDS_BYTES) != hipSuccess || per_cu < 1) { fprintf(stderr, "kernel_launch: occupancy query says %d\n", per_cu); (void)hipGetLastError(); per_cu = 1; }
        grid = cus;
    }
    if (grid < 0) return;
    (void)hipMemsetAsync((char*)d_ws + WS_CTL, 0, 1 * MiB, stream);
    Args a{};
    for (int i = 0; i < 28; ++i) a.in[i] = (const float*)d_in[i];
    a.out = (float*)d_out; a.ws = (unsigned char*)d_ws;
    void* kargs[] = {&a};
    hipError_t e = hipLaunchCooperativeKernel((const void*)fwd_kernel, dim3(grid), dim3(NTHREADS), kargs, LDS_BYTES, stream);
    if (e != hipSuccess) fprintf(stderr, "kernel_launch: cooperative launch failed: %s (grid %d)\n", hipGetErrorString(e), grid);
}
```
